# Optimizing an MI355X kernel written in HIP

```python
import jax, jax.numpy as jnp
from jax import lax
import numpy as np

D_MODEL = 1024
BATCH = 16
SEQ = 2048
DEPTH = 4

N_MIXERS = 2
N_HEADS = 16
N_KV_HEADS = 4
HEAD_DIM = D_MODEL // N_HEADS
GROUP = N_HEADS // N_KV_HEADS
QKV_DIM = (N_HEADS + 2 * N_KV_HEADS) * HEAD_DIM
WINDOW = 128
BLOCK = 128
ROPE_THETA = 10000.0
CONV_WIDTH = 3
D_FF = 2816
N_SUBLAYERS = 3
N_ADA = 3 * N_SUBLAYERS
EPS = 1e-6
N_ATTN_LAYERS = (DEPTH + 1) // 2
N_CONV_LAYERS = DEPTH // 2

kernel_name = "hybrid_swa_sink_shortconv_macaron_adaln"


def rms_norm(x, gain):
    xf = x.astype(jnp.float32)
    y = xf * lax.rsqrt(jnp.mean(xf * xf, axis=-1, keepdims=True) + EPS)
    return (y * gain.astype(jnp.float32)).astype(x.dtype)


def modulate(h, shift, scale):
    return h * (1.0 + scale[:, None, :]) + shift[:, None, :]


def swiglu(h, w_up, w_down):
    gate, up = jnp.split(h @ w_up, 2, axis=-1)
    return (jax.nn.silu(gate) * up) @ w_down


def rope_tables(positions, dtype):
    inv_freq = ROPE_THETA ** (-jnp.arange(0, HEAD_DIM, 2, dtype=jnp.float32) / HEAD_DIM)
    ang = positions.astype(jnp.float32)[..., None] * inv_freq
    return jnp.cos(ang)[:, :, None, :].astype(dtype), jnp.sin(ang)[:, :, None, :].astype(dtype)


def apply_rope(t, cos, sin):
    t1, t2 = jnp.split(t, 2, axis=-1)
    return jnp.concatenate([t1 * cos - t2 * sin, t2 * cos + t1 * sin], axis=-1)


def swa_sink_attention(h, cos, sin, w_qkv, b_qkv, q_gain, k_gain, sinks, w_o, b_o):
    b, s, _ = h.shape
    nb = s // BLOCK
    qkv = h @ w_qkv + b_qkv
    q, k, v = jnp.split(qkv, [N_HEADS * HEAD_DIM, (N_HEADS + N_KV_HEADS) * HEAD_DIM], axis=-1)
    q = q.reshape(b, s, N_HEADS, HEAD_DIM)
    k = k.reshape(b, s, N_KV_HEADS, HEAD_DIM)
    v = v.reshape(b, s, N_KV_HEADS, HEAD_DIM)
    q = apply_rope(rms_norm(q, q_gain), cos, sin)
    k = apply_rope(rms_norm(k, k_gain), cos, sin)
    qb = q.reshape(b, nb, BLOCK, N_KV_HEADS, GROUP, HEAD_DIM)

    def banded(t):
        tb = t.reshape(b, nb, BLOCK, N_KV_HEADS, HEAD_DIM)
        prev = jnp.pad(tb[:, :-1], ((0, 0), (1, 0), (0, 0), (0, 0), (0, 0)))
        return jnp.concatenate([prev, tb], axis=2)

    kb, vb = banded(k), banded(v)
    scores = jnp.einsum('bnqkgd,bnskd->bnkgqs', qb, kb,
                        preferred_element_type=jnp.float32) * (HEAD_DIM ** -0.5)
    blk = jnp.arange(nb)[:, None, None] * BLOCK
    q_pos = blk + jnp.arange(BLOCK)[None, :, None]
    k_pos = blk - BLOCK + jnp.arange(2 * BLOCK)[None, None, :]
    rel = q_pos - k_pos
    mask = (rel >= 0) & (rel < WINDOW) & (k_pos >= 0)
    scores = jnp.where(mask[None, :, None, None], scores, -jnp.inf)
    sink = jnp.broadcast_to(sinks.astype(jnp.float32).reshape(1, 1, N_KV_HEADS, GROUP, 1, 1),
                            scores.shape[:-1] + (1,))
    probs = jax.nn.softmax(jnp.concatenate([scores, sink], axis=-1), axis=-1)[..., :-1]
    out = jnp.einsum('bnkgqs,bnskd->bnqkgd', probs.astype(vb.dtype), vb)
    return out.reshape(b, s, N_HEADS * HEAD_DIM) @ w_o + b_o


def short_gated_conv(h, w_in, conv_w, w_out):
    gb, gc, v = jnp.split(h @ w_in, 3, axis=-1)
    u = gc * v
    conv = lax.conv_general_dilated(
        u, conv_w[:, None, :], window_strides=(1,), padding=[(CONV_WIDTH - 1, 0)],
        dimension_numbers=('NWC', 'WIO', 'NWC'), feature_group_count=D_MODEL)
    return (gb * conv) @ w_out


def setup_inputs(seed: int = 0) -> dict:
    key = jax.random.key(seed)
    ks = jax.random.split(key, 20)
    f32 = jnp.float32
    d = D_MODEL
    nrm = lambda k, shape, fan_in: jax.random.normal(k, shape, f32) * (fan_in ** -0.5)
    x = jax.random.normal(ks[0], (BATCH, SEQ, d), f32)
    c = jax.random.normal(ks[1], (BATCH, d), f32)
    positions = (jnp.arange(SEQ, dtype=jnp.int32)[None, :]
                 + jax.random.randint(ks[2], (BATCH, 1), 0, 4096, dtype=jnp.int32))
    norm_gain = 1.0 + 0.05 * jax.random.normal(ks[3], (DEPTH, N_SUBLAYERS, d), f32)
    w_ada = nrm(ks[4], (DEPTH, d, N_ADA * d), d)
    b_ada = 0.02 * jax.random.normal(ks[5], (DEPTH, N_ADA * d), f32)
    w_ffn_up = nrm(ks[6], (DEPTH, 2, d, 2 * D_FF), d)
    w_ffn_down = nrm(ks[7], (DEPTH, 2, D_FF, d), D_FF)
    attn_w_qkv = nrm(ks[8], (N_ATTN_LAYERS, d, QKV_DIM), d)
    attn_b_qkv = 0.02 * jax.random.normal(ks[9], (N_ATTN_LAYERS, QKV_DIM), f32)
    attn_q_gain = 1.0 + 0.05 * jax.random.normal(ks[10], (N_ATTN_LAYERS, HEAD_DIM), f32)
    attn_k_gain = 1.0 + 0.05 * jax.random.normal(ks[11], (N_ATTN_LAYERS, HEAD_DIM), f32)
    attn_sinks = 0.5 * jax.random.normal(ks[12], (N_ATTN_LAYERS, N_HEADS), f32)
    attn_w_o = nrm(ks[13], (N_ATTN_LAYERS, N_HEADS * HEAD_DIM, d), N_HEADS * HEAD_DIM)
    attn_b_o = 0.02 * jax.random.normal(ks[14], (N_ATTN_LAYERS, d), f32)
    conv_w_in = nrm(ks[15], (N_CONV_LAYERS, d, 3 * d), d)
    conv_w = nrm(ks[16], (N_CONV_LAYERS, CONV_WIDTH, d), CONV_WIDTH)
    conv_w_out = nrm(ks[17], (N_CONV_LAYERS, d, d), d)
    return {"x": x, "c": c, "positions": positions, "norm_gain": norm_gain,
            "w_ada": w_ada, "b_ada": b_ada, "w_ffn_up": w_ffn_up, "w_ffn_down": w_ffn_down,
            "attn_w_qkv": attn_w_qkv, "attn_b_qkv": attn_b_qkv, "attn_q_gain": attn_q_gain,
            "attn_k_gain": attn_k_gain, "attn_sinks": attn_sinks, "attn_w_o": attn_w_o,
            "attn_b_o": attn_b_o, "conv_w_in": conv_w_in, "conv_w": conv_w,
            "conv_w_out": conv_w_out}


def reference(x, c, positions, norm_gain, w_ada, b_ada, w_ffn_up, w_ffn_down,
              attn_w_qkv, attn_b_qkv, attn_q_gain, attn_k_gain, attn_sinks, attn_w_o,
              attn_b_o, conv_w_in, conv_w, conv_w_out):
    cos, sin = rope_tables(positions, x.dtype)
    c_act = jax.nn.silu(c)
    for i in range(DEPTH):
        mod = c_act @ w_ada[i] + b_ada[i]
        sh1, sc1, g1, sh2, sc2, g2, sh3, sc3, g3 = jnp.split(mod, N_ADA, axis=-1)
        h = modulate(rms_norm(x, norm_gain[i, 0]), sh1, sc1)
        x = x + 0.5 * g1[:, None, :] * swiglu(h, w_ffn_up[i, 0], w_ffn_down[i, 0])
        h = modulate(rms_norm(x, norm_gain[i, 1]), sh2, sc2)
        j = i // N_MIXERS
        if i % N_MIXERS == 0:
            y = swa_sink_attention(h, cos, sin, attn_w_qkv[j], attn_b_qkv[j], attn_q_gain[j],
                                   attn_k_gain[j], attn_sinks[j], attn_w_o[j], attn_b_o[j])
        else:
            y = short_gated_conv(h, conv_w_in[j], conv_w[j], conv_w_out[j])
        x = x + g2[:, None, :] * y
        h = modulate(rms_norm(x, norm_gain[i, 2]), sh3, sc3)
        x = x + 0.5 * g3[:, None, :] * swiglu(h, w_ffn_up[i, 1], w_ffn_down[i, 1])
    return x
```

```cpp
#include <hip/hip_runtime.h>
#include <hip/hip_cooperative_groups.h>
#include <cstdio>
#include <cstdint>
namespace cg = cooperative_groups;
namespace pg8 {
#define PG8_LAS __attribute__((address_space(3)))
typedef unsigned short bf16_t;
typedef short bf16x8 __attribute__((ext_vector_type(8)));
typedef float f32x4 __attribute__((ext_vector_type(4)));
typedef unsigned u32x4 __attribute__((ext_vector_type(4)));
constexpr int BM = 256, BK = 64, HALF = 128, HTB = HALF * BK * 2  , STAGE_BYTES = 8 * HTB, NXCD = 8, WGM = 8;

__host__ __device__ __forceinline__ int lds_byte(int r, int c) { const int st = (r >> 4) * 2 + (c >> 5), rr = r & 15, cc = c & 31, ob = rr * 64 + cc * 2; return st * 1024 + (ob ^ (((ob >> 9) & 1) << 5)); }
__host__ __device__ __forceinline__ void stage_rc(int b, int& R, int& C) { const int st = b / 1024, sb = b % 1024, swz = sb ^ (((sb >> 9) & 1) << 5); R = (st >> 1) * 16 + swz / 64; C = (st & 1) * 32 + (swz % 64) / 2; }
__host__ __device__ __forceinline__ int perm32(int rho) { const int n = rho >> 4, i = rho & 15; return 8 * (i >> 2) + 4 * n + (i & 3); }

struct Unit { int pm, pn; };
struct Gemm { const bf16_t* A; const bf16_t* Bt; int M, N, K; };

struct StaticOrder {
    int nM, nN, nwg, G, c;
    __host__ __device__ void init(int M, int N, int G_, int c_) { nM = M / BM; nN = N / BM; nwg = nM * nN; G = G_; c = c_; }
    __host__ __device__ bool next(int i, Unit& u) const {
        const long L = (long)i * G + c; if (L >= nwg) return false;
        int wgid = (int)L; { const int q = nwg / NXCD, r = nwg % NXCD, xcd = wgid % NXCD, off = wgid / NXCD; wgid = (xcd < r ? xcd * (q + 1) : r * (q + 1) + (xcd - r) * q) + off; }
        const int nig = WGM * nN, gid = wgid / nig, fm = gid * WGM, gsz = (nM - fm) < WGM ? (nM - fm) : WGM;
        u.pm = fm + ((wgid % nig) % gsz); u.pn = (wgid % nig) / gsz; return true;
    }
    __device__ __forceinline__ void a_ready(const Unit&) const {}
    __device__ __forceinline__ void done(const Unit&) const {}
};

typedef float f32x2 __attribute__((ext_vector_type(2)));
typedef __bf16 bf16x2_t __attribute__((ext_vector_type(2)));
__device__ __forceinline__ unsigned cvt_pk_bf16(float lo, float hi) { const f32x2 v = {lo, hi}; const bf16x2_t b = __builtin_convertvector(v, bf16x2_t); return __builtin_bit_cast(unsigned, b); }
typedef unsigned u32x2 __attribute__((ext_vector_type(2)));
#define PG8_GAS __attribute__((address_space(1)))
__device__ __forceinline__ f32x4 ld4(const float* p) { return *(const PG8_GAS f32x4*)p; }
__device__ __forceinline__ u32x4 ld4u(const void* p) { return *(const PG8_GAS u32x4*)p; }
__device__ __forceinline__ void st4f(float* p, f32x4 v) { *(PG8_GAS f32x4*)p = v; }
__device__ __forceinline__ void st4u(void* p, u32x4 v) { *(PG8_GAS u32x4*)p = v; }
__device__ __forceinline__ u32x4 pack8(f32x4 a, f32x4 b) { u32x4 w; w.x = cvt_pk_bf16(a[0], a[1]); w.y = cvt_pk_bf16(a[2], a[3]); w.z = cvt_pk_bf16(b[0], b[1]); w.w = cvt_pk_bf16(b[2], b[3]); return w; }
__device__ __forceinline__ float silu_f(float g) { return g * __builtin_amdgcn_rcpf(1.f + __builtin_amdgcn_exp2f(-1.44269504f * g)); }
__device__ __forceinline__ float rstd_of(float ss, float inv_n) { return 1.0f / sqrtf(ss * inv_n + 1e-6f); }
__device__ __forceinline__ float rstd_row(const float* rsp, int row) {
    const f32x4 a = ld4(rsp + (size_t)row * 16), b = ld4(rsp + (size_t)row * 16 + 4), c = ld4(rsp + (size_t)row * 16 + 8), d = ld4(rsp + (size_t)row * 16 + 12);
    const float s = (((a[0] + a[1]) + (a[2] + a[3])) + ((b[0] + b[1]) + (b[2] + b[3]))) + (((c[0] + c[1]) + (c[2] + c[3])) + ((d[0] + d[1]) + (d[2] + d[3])));
    return rstd_of(s, 1.f / 1024.f);
}

__device__ __forceinline__ void rstd8(const float* rsp, int row0, int fq, float (&r)[2][4]) {
    f32x4 p[2][4];
#pragma unroll
    for (int ai = 0; ai < 2; ++ai)
#pragma unroll
        for (int m = 0; m < 4; ++m) p[ai][m] = ld4(rsp + (size_t)(row0 + ai * 128 + m * 16) * 16 + 4 * fq);
#pragma unroll
    for (int ai = 0; ai < 2; ++ai)
#pragma unroll
        for (int m = 0; m < 4; ++m) { float s = (p[ai][m][0] + p[ai][m][1]) + (p[ai][m][2] + p[ai][m][3]); s += __shfl_xor(s, 16); s += __shfl_xor(s, 32);
            r[ai][m] = __builtin_amdgcn_rsqf(s * (1.f / 1024.f) + 1e-6f); }
}

struct EpiUp {
    static constexpr bool PERM = true, AFTER_DRAIN = false;
    bf16_t* O; const float* rowss; const float* sb; PG8_LAS float* rl; mutable int last_pm;
    __device__ __forceinline__ void operator()(const f32x4 (&acc)[2][2][4][2], const Unit& u, int wr, int wc, int fr, int fq) const {
        const int b = u.pm >> 3;
        const float* sbp = sb + (size_t)b * 5632 + u.pn * 256 + wc * 32 + 8 * fq;
        f32x4 sg[2], su[2];
#pragma unroll
        for (int n = 0; n < 2; ++n) { sg[n] = ld4(sbp + 4 * n); su[n] = ld4(sbp + 128 + 4 * n); }
        const int row0 = u.pm * 256 + wr * 64 + fr;
        bf16_t* ob = O + u.pn * 128 + wc * 32 + 8 * fq;
        float rr[2][4];
        PG8_LAS float* rw = rl + (wr * 4 + wc) * 128 + fr;
        if (u.pm != last_pm) {
            rstd8(rowss, row0, fq, rr);
            if (fq == 0) {
#pragma unroll
                for (int ai = 0; ai < 2; ++ai)
#pragma unroll
                    for (int m = 0; m < 4; ++m) rw[(ai * 4 + m) * 16] = rr[ai][m]; }
            last_pm = u.pm;
        } else {
#pragma unroll
            for (int ai = 0; ai < 2; ++ai)
#pragma unroll
                for (int m = 0; m < 4; ++m) rr[ai][m] = rw[(ai * 4 + m) * 16];
        }
#pragma unroll
        for (int ai = 0; ai < 2; ++ai)
#pragma unroll
            for (int m = 0; m < 4; ++m) {
                const int row = row0 + ai * 128 + m * 16; const float r = rr[ai][m]; const f32x2 r2 = {r, r};
                u32x4 w;
#pragma unroll
                for (int n = 0; n < 2; ++n) { const f32x4 ga = acc[ai][0][m][n], ua = acc[ai][1][m][n];
#pragma unroll
                    for (int h = 0; h < 2; ++h) {
                        const f32x2 g2 = (f32x2){ga[2 * h], ga[2 * h + 1]} * r2 + (f32x2){sg[n][2 * h], sg[n][2 * h + 1]};
                        const f32x2 u2 = (f32x2){ua[2 * h], ua[2 * h + 1]} * r2 + (f32x2){su[n][2 * h], su[n][2 * h + 1]};
                        const f32x2 t2 = g2 * (-1.44269504f);
                        f32x2 d2; d2.x = __builtin_amdgcn_exp2f(t2.x); d2.y = __builtin_amdgcn_exp2f(t2.y); d2 = d2 + 1.0f;
                        f32x2 q2; q2.x = __builtin_amdgcn_rcpf(d2.x); q2.y = __builtin_amdgcn_rcpf(d2.y);
                        const f32x2 a2 = (g2 * u2) * q2;
                        w[2 * n + h] = cvt_pk_bf16(a2.x, a2.y); } }
                st4u(ob + (size_t)row * 2816, w);
            }
    }
};

__device__ __forceinline__ f32x4 bf4_lo(u32x4 w) { f32x4 r; r[0] = __builtin_bit_cast(float, w[0] << 16); r[1] = __builtin_bit_cast(float, w[0] & 0xffff0000u); r[2] = __builtin_bit_cast(float, w[1] << 16); r[3] = __builtin_bit_cast(float, w[1] & 0xffff0000u); return r; }
__device__ __forceinline__ f32x4 bf4_hi(u32x4 w) { f32x4 r; r[0] = __builtin_bit_cast(float, w[2] << 16); r[1] = __builtin_bit_cast(float, w[2] & 0xffff0000u); r[2] = __builtin_bit_cast(float, w[3] << 16); r[3] = __builtin_bit_cast(float, w[3] & 0xffff0000u); return r; }
struct EpiResid {
    static constexpr bool PERM = true, AFTER_DRAIN = false;
    const void* base; void* out; int base_f32, out_f32; const float* gate; const float* bias;
    bf16_t* AP; const float* Gn; float* nrowss;
    __device__ __forceinline__ void operator()(const f32x4 (&acc)[2][2][4][2], const Unit& u, int wr, int wc, int fr, int fq) const {
        const int b = u.pm >> 3;
        const int col0 = u.pn * 256 + wc * 32 + 8 * fq;
        f32x4 gt[2][2], bs[2][2], G[2][2];
#pragma unroll
        for (int bj = 0; bj < 2; ++bj)
#pragma unroll
            for (int n = 0; n < 2; ++n) { const int c = col0 + 128 * bj + 4 * n;
                gt[bj][n] = ld4(gate + b * 1024 + c);
                bs[bj][n] = bias ? ld4(bias + c) : (f32x4){0.f, 0.f, 0.f, 0.f};
                G[bj][n] = AP ? ld4(Gn + b * 1024 + c) : (f32x4){0.f, 0.f, 0.f, 0.f}; }
        const int row0 = u.pm * 256 + wr * 64 + fr;
#pragma unroll
        for (int ai = 0; ai < 2; ++ai)
#pragma unroll
            for (int m = 0; m < 4; ++m) {
                const int row = row0 + ai * 128 + m * 16; const size_t off = (size_t)row * 1024 + col0; float ss = 0.f;
#pragma unroll
                for (int bj = 0; bj < 2; ++bj) { f32x4 xin[2], xn[2];
                    if (base_f32) { xin[0] = ld4((const float*)base + off + 128 * bj); xin[1] = ld4((const float*)base + off + 128 * bj + 4); }
                    else { const u32x4 w = ld4u((const bf16_t*)base + off + 128 * bj); xin[0] = bf4_lo(w); xin[1] = bf4_hi(w); }
#pragma unroll
                    for (int n = 0; n < 2; ++n) { xn[n] = xin[n] + gt[bj][n] * (acc[ai][bj][m][n] + bs[bj][n]);
                        ss += (xn[n][0] * xn[n][0] + xn[n][1] * xn[n][1]) + (xn[n][2] * xn[n][2] + xn[n][3] * xn[n][3]); }
                    if (out_f32) { st4f((float*)out + off + 128 * bj, xn[0]); st4f((float*)out + off + 128 * bj + 4, xn[1]); }
                    else st4u((bf16_t*)out + off + 128 * bj, pack8(xn[0], xn[1]));
                    if (AP) st4u(AP + off + 128 * bj, pack8(xn[0] * G[bj][0], xn[1] * G[bj][1])); }
                if (AP) { ss += __shfl_xor(ss, 16); ss += __shfl_xor(ss, 32); if (fq == 0) *(PG8_GAS float*)(nrowss + (size_t)row * 16 + u.pn * 4 + wc) = ss; }
                if (m & 1) asm volatile("" ::: "memory");
            }
    }
};

struct EpiQKV {
    static constexpr bool PERM = true, AFTER_DRAIN = false;
    bf16_t *Q, *K, *V; const float* rowss; const float* sb; const float* qg; const float* kg; const float* cosT; const float* sinT;
    __device__ __forceinline__ void operator()(const f32x4 (&acc)[2][2][4][2], const Unit& u, int wr, int wc, int fr, int fq) const {
        const int b = u.pm >> 3;
        const float* sbp = sb + (size_t)b * 1536 + u.pn * 256 + wc * 32 + 8 * fq;
        f32x4 sv[2][2], gv[2][2];
        const int typ = u.pn < 4 ? 0 : (u.pn == 4 ? 1 : 2);
        const float* gp = (typ == 0 ? qg : kg) + 8 * fq;
#pragma unroll
        for (int bj = 0; bj < 2; ++bj)
#pragma unroll
            for (int n = 0; n < 2; ++n) { sv[bj][n] = ld4(sbp + 128 * bj + 4 * n); gv[bj][n] = ld4(gp + 32 * bj + 4 * n); }
        const int row0 = u.pm * 256 + wr * 64 + fr;
        float rr[2][4]; rstd8(rowss, row0, fq, rr);
        bf16_t* dst; int pitch; float osc = 1.f;
        if (typ == 0) { dst = Q + (u.pn * 4 + wc) * 64 + 8 * fq; pitch = 1024; osc = 0.125f * 1.44269504f; }
        else if (typ == 1) { dst = K + wc * 64 + 8 * fq; pitch = 256; }
        else { dst = V + wc * 64 + 8 * fq; pitch = 256; }
#pragma unroll
        for (int ai = 0; ai < 2; ++ai)
#pragma unroll
            for (int m = 0; m < 4; ++m) {
                const int row = row0 + ai * 128 + m * 16; const float r = rr[ai][m];
                f32x4 v[2][2]; float ss = 0.f;
#pragma unroll
                for (int bj = 0; bj < 2; ++bj)
#pragma unroll
                    for (int n = 0; n < 2; ++n) { v[bj][n] = acc[ai][bj][m][n] * r + sv[bj][n];
                        ss += (v[bj][n][0] * v[bj][n][0] + v[bj][n][1] * v[bj][n][1]) + (v[bj][n][2] * v[bj][n][2] + v[bj][n][3] * v[bj][n][3]); }
                bf16_t* dp = dst + (size_t)row * pitch;
                if (typ == 2) {
                    st4u(dp, pack8(v[0][0], v[0][1])); st4u(dp + 32, pack8(v[1][0], v[1][1]));
                } else {
                    ss += __shfl_xor(ss, 16); ss += __shfl_xor(ss, 32);
                    const float rn = rstd_of(ss, 1.f / 64.f) * osc;
                    f32x4 o1[2], o2[2];
#pragma unroll
                    for (int n = 0; n < 2; ++n) { const f32x4 cs = ld4(cosT + (size_t)row * 32 + 8 * fq + 4 * n), sn = ld4(sinT + (size_t)row * 32 + 8 * fq + 4 * n);
                        const f32x4 y1 = v[0][n] * gv[0][n] * rn, y2 = v[1][n] * gv[1][n] * rn;
                        o1[n] = y1 * cs - y2 * sn; o2[n] = y2 * cs + y1 * sn; }
                    st4u(dp, pack8(o1[0], o1[1])); st4u(dp + 32, pack8(o2[0], o2[1]));
                }
            }
    }
};

struct EpiCin {
    static constexpr bool PERM = true, AFTER_DRAIN = false;
    bf16_t *U, *GB; const float* rowss; const float* sb;
    __device__ __forceinline__ void operator()(const f32x4 (&acc)[2][2][4][2], const Unit& u, int wr, int wc, int fr, int fq) const {
        const int b = u.pm >> 3;
        const float* sbp = sb + (size_t)b * 3072 + u.pn * 256 + wc * 32 + 8 * fq;
        f32x4 sv[2][2];
#pragma unroll
        for (int bj = 0; bj < 2; ++bj)
#pragma unroll
            for (int n = 0; n < 2; ++n) sv[bj][n] = ld4(sbp + 128 * bj + 4 * n);
        const int row0 = u.pm * 256 + wr * 64 + fr;
        float rr[2][4]; rstd8(rowss, row0, fq, rr);
        const bool isu = u.pn < 8;
        bf16_t* ob = isu ? U + u.pn * 128 + wc * 32 + 8 * fq : GB + (u.pn - 8) * 256 + wc * 32 + 8 * fq;
#pragma unroll
        for (int ai = 0; ai < 2; ++ai)
#pragma unroll
            for (int m = 0; m < 4; ++m) {
                const int row = row0 + ai * 128 + m * 16; const float r = rr[ai][m];
                f32x4 v[2][2];
#pragma unroll
                for (int bj = 0; bj < 2; ++bj)
#pragma unroll
                    for (int n = 0; n < 2; ++n) v[bj][n] = acc[ai][bj][m][n] * r + sv[bj][n];
                bf16_t* dp = ob + (size_t)row * 1024;
                if (isu) { st4u(dp, pack8(v[0][0] * v[1][0], v[0][1] * v[1][1])); }
                else { st4u(dp, pack8(v[0][0], v[0][1])); st4u(dp + 128, pack8(v[1][0], v[1][1])); }
            }
    }
};


struct StaticOrderPF : StaticOrder {
    const float* pbase; PG8_LAS unsigned char* dummy; int ptid;
    __device__ __forceinline__ void a_ready(const Unit& u) const {
#ifdef NO_PF
        return;
#endif
        const char* p = (const char*)pbase + ((size_t)(u.pm * 256) * 1024 + u.pn * 256) * 4;
#pragma unroll
        for (int i = 0; i < 4; ++i) { const int line = ptid + 512 * i;
            __builtin_amdgcn_global_load_lds((const unsigned*)(p + (size_t)(line >> 3) * 4096 + (line & 7) * 128), (PG8_LAS unsigned*)dummy, 4, 0, 0); }
    }
};
template <class Epi, class Sched, bool ALIGN_EPI = false, bool SP2 = false>
__device__ __forceinline__ void gemm_phase(PG8_LAS unsigned char* lds, const Gemm g, const Sched& S, const Epi& E, const int tid_in) {
    const int tid = tid_in, wid = __builtin_amdgcn_readfirstlane(tid >> 6), lane = tid & 63, wr = wid >> 2, wc = wid & 3, fr = lane & 15, fq = lane >> 4;
    const int K = g.K, nt = K / BK;
    unsigned voffA[2], voffB[2];
#pragma unroll
    for (int i = 0; i < 2; ++i) { int R, C; stage_rc(tid * 16 + i * 8192, R, C); const int Rb = Epi::PERM ? ((R & ~31) + perm32(R & 31)) : R;
        voffA[i] = (unsigned)(R * K + C) * 2u; voffB[i] = (unsigned)(Rb * K + C) * 2u; }
    const size_t kstep = (size_t)(BK * 2);
    const size_t hstep = (size_t)HALF * K * 2;
    const size_t tstep = 2 * hstep;
    const unsigned ldsw = (unsigned)wid * 1024u;
    const int aoff = lds_byte(wr * 64 + fr, fq * 8), boff = lds_byte(wc * 32 + fr, fq * 8);
#define PG8_SA(b, h) (((b) * 2 + (h)) * HTB)
#define PG8_SB(b, h) ((4 + (b) * 2 + (h)) * HTB)
#define PG8_STAGE(bufoff, gbase, voff) do { _Pragma("unroll") for (int _i = 0; _i < 2; ++_i) \
        __builtin_amdgcn_global_load_lds((const unsigned*)((const char*)(gbase) + (voff)[_i]), (PG8_LAS unsigned*)(lds + (bufoff) + ldsw + _i * 8192), 16, 0, 0); } while (0)
#define PG8_LDA(dst, b, h) do { _Pragma("unroll") for (int m = 0; m < 4; ++m) _Pragma("unroll") for (int k = 0; k < 2; ++k) dst[m][k] = *(const PG8_LAS bf16x8*)(lds + PG8_SA(b, h) + aoff + m * 2048 + k * 1024); } while (0)
#define PG8_LDB(dst, b, h) do { _Pragma("unroll") for (int n = 0; n < 2; ++n) _Pragma("unroll") for (int k = 0; k < 2; ++k) dst[n][k] = *(const PG8_LAS bf16x8*)(lds + PG8_SB(b, h) + boff + n * 2048 + k * 1024); } while (0)
#define PG8_MMA(ai, bj, At, Bt) do { __builtin_amdgcn_s_setprio(1); _Pragma("unroll") for (int m = 0; m < 4; ++m) _Pragma("unroll") for (int n = 0; n < 2; ++n) _Pragma("unroll") for (int k = 0; k < 2; ++k) \
        acc[ai][bj][m][n] = __builtin_amdgcn_mfma_f32_16x16x32_bf16(Bt[n][k], At[m][k], acc[ai][bj][m][n], 0, 0, 0); __builtin_amdgcn_s_setprio(0); } while (0)
#define PG8_WAIT_V(n) asm volatile("s_waitcnt vmcnt(" #n ")" ::: "memory")
#define PG8_WAIT_L(n) asm volatile("s_waitcnt lgkmcnt(" #n ")" ::: "memory")
#define PG8_BAR __builtin_amdgcn_s_barrier()
#define PG8_SCHED __builtin_amdgcn_sched_barrier(0)
    Unit cur, nxt; int ui = 0;
    if (!S.next(0, cur)) return;
    f32x4 acc[2][2][4][2];
#pragma unroll
    for (int a = 0; a < 2; ++a)
#pragma unroll
        for (int b = 0; b < 2; ++b)
#pragma unroll
            for (int m = 0; m < 4; ++m)
#pragma unroll
                for (int n = 0; n < 2; ++n) acc[a][b][m][n] = (f32x4){0.f, 0.f, 0.f, 0.f};
    bf16x8 At[4][2], B0[2][2], B1[2][2];
    const char* cA = (const char*)g.A + (size_t)cur.pm * tstep; const char* cB = (const char*)g.Bt + (size_t)cur.pn * tstep;
    S.a_ready(cur);
    if constexpr (SP2) {
        PG8_STAGE(PG8_SB(0, 0), cB, voffB); PG8_STAGE(PG8_SB(0, 1), cB + hstep, voffB); PG8_STAGE(PG8_SA(0, 0), cA, voffA); PG8_STAGE(PG8_SA(0, 1), cA + hstep, voffA);
        if (wr == 1) PG8_BAR;
        PG8_WAIT_V(2); PG8_BAR;
        PG8_STAGE(PG8_SB(1, 0), cB + kstep, voffB); PG8_STAGE(PG8_SA(1, 0), cA + kstep, voffA); PG8_STAGE(PG8_SB(1, 1), cB + hstep + kstep, voffB);
        PG8_WAIT_V(6); PG8_BAR;
    } else {
        PG8_STAGE(PG8_SB(0, 0), cB, voffB); PG8_STAGE(PG8_SA(0, 0), cA, voffA); PG8_STAGE(PG8_SB(0, 1), cB + hstep, voffB); PG8_STAGE(PG8_SA(0, 1), cA + hstep, voffA);
        if (wr == 1) PG8_BAR;
        PG8_WAIT_V(4); PG8_BAR;
        PG8_STAGE(PG8_SB(1, 0), cB + kstep, voffB); PG8_STAGE(PG8_SA(1, 0), cA + kstep, voffA); PG8_STAGE(PG8_SB(1, 1), cB + hstep + kstep, voffB);
        PG8_WAIT_V(6); PG8_BAR;
    }
    for (;;) {
        const bool has_next = S.next(ui + 1, nxt);
        const char* nA = has_next ? (const char*)g.A + (size_t)nxt.pm * tstep : cA; const char* nB = has_next ? (const char*)g.Bt + (size_t)nxt.pn * tstep : cB;
        for (int t = 0; t < nt; t += 2) {
            const bool last = (t == nt - 2);
            const char* a1 = cA + (size_t)(t + 1) * kstep;
            const char* a2 = last ? nA : cA + (size_t)(t + 2) * kstep; const char* b2 = last ? nB : cB + (size_t)(t + 2) * kstep;
            const char* a3 = a2 + kstep; const char* b3 = b2 + kstep;
            if (last && has_next) S.a_ready(nxt);
            if constexpr (SP2) {
            PG8_LDB(B0, 0, 0); PG8_LDB(B1, 0, 1); PG8_SCHED; PG8_LDA(At, 0, 0); PG8_STAGE(PG8_SA(1, 1), a1 + hstep, voffA);
            PG8_WAIT_V(8); PG8_WAIT_L(0); PG8_BAR; PG8_MMA(0, 0, At, B0); PG8_MMA(0, 1, At, B1); PG8_BAR; PG8_SCHED;
            PG8_LDA(At, 0, 1); PG8_STAGE(PG8_SB(0, 0), b2, voffB); PG8_STAGE(PG8_SB(0, 1), b2 + hstep, voffB); PG8_STAGE(PG8_SA(0, 0), a2, voffA);
            PG8_WAIT_V(8); PG8_WAIT_L(0); PG8_BAR; PG8_MMA(1, 0, At, B0); PG8_MMA(1, 1, At, B1); PG8_BAR; PG8_SCHED;
            PG8_LDB(B0, 1, 0); PG8_LDB(B1, 1, 1); PG8_SCHED; PG8_LDA(At, 1, 0); PG8_STAGE(PG8_SA(0, 1), a2 + hstep, voffA);
            PG8_WAIT_V(8); PG8_WAIT_L(0); PG8_BAR; PG8_MMA(0, 0, At, B0); PG8_MMA(0, 1, At, B1); PG8_BAR; PG8_SCHED;
            PG8_LDA(At, 1, 1); PG8_STAGE(PG8_SB(1, 0), b3, voffB); PG8_STAGE(PG8_SB(1, 1), b3 + hstep, voffB); PG8_STAGE(PG8_SA(1, 0), a3, voffA);
            PG8_WAIT_V(8); PG8_WAIT_L(0); PG8_BAR; PG8_MMA(1, 0, At, B0); PG8_MMA(1, 1, At, B1); PG8_BAR; PG8_SCHED;
            } else {
            PG8_LDB(B0, 0, 0); PG8_SCHED; PG8_LDA(At, 0, 0); PG8_STAGE(PG8_SA(1, 1), a1 + hstep, voffA);
            PG8_WAIT_L(8); PG8_BAR; PG8_WAIT_L(0); PG8_MMA(0, 0, At, B0); PG8_BAR; PG8_SCHED;
            PG8_LDB(B1, 0, 1); PG8_STAGE(PG8_SB(0, 0), b2, voffB);
            PG8_BAR; PG8_WAIT_L(0); PG8_MMA(0, 1, At, B1); PG8_BAR;
            PG8_LDA(At, 0, 1); PG8_STAGE(PG8_SA(0, 0), a2, voffA);
            PG8_BAR; PG8_WAIT_L(0); PG8_MMA(1, 0, At, B0); PG8_BAR; PG8_SCHED;
            PG8_STAGE(PG8_SB(0, 1), b2 + hstep, voffB);
            PG8_WAIT_V(6); PG8_BAR; PG8_MMA(1, 1, At, B1); PG8_BAR;
            PG8_LDB(B0, 1, 0); PG8_SCHED; PG8_LDA(At, 1, 0); PG8_STAGE(PG8_SA(0, 1), a2 + hstep, voffA);
            PG8_WAIT_L(8); PG8_BAR; PG8_WAIT_L(0); PG8_MMA(0, 0, At, B0); PG8_BAR; PG8_SCHED;
            PG8_LDB(B1, 1, 1); PG8_STAGE(PG8_SB(1, 0), b3, voffB);
            PG8_BAR; PG8_WAIT_L(0); PG8_MMA(0, 1, At, B1); PG8_BAR;
            PG8_LDA(At, 1, 1); PG8_STAGE(PG8_SA(1, 0), a3, voffA);
            PG8_BAR; PG8_WAIT_L(0); PG8_MMA(1, 0, At, B0); PG8_BAR; PG8_SCHED;
            PG8_STAGE(PG8_SB(1, 1), b3 + hstep, voffB);
            PG8_WAIT_V(6); PG8_BAR; PG8_MMA(1, 1, At, B1); PG8_BAR;
            }
        }
        if constexpr (ALIGN_EPI) { if (wr == 0) PG8_BAR; }
        if constexpr (!Epi::AFTER_DRAIN) { E(acc, cur, wr, wc, fr, fq); S.done(cur); }
        if (!has_next) break;
#pragma unroll
        for (int a = 0; a < 2; ++a)
#pragma unroll
            for (int b = 0; b < 2; ++b)
#pragma unroll
                for (int m = 0; m < 4; ++m)
#pragma unroll
                    for (int n = 0; n < 2; ++n) acc[a][b][m][n] = (f32x4){0.f, 0.f, 0.f, 0.f};
        cur = nxt; cA = nA; cB = nB; ++ui;
        if constexpr (ALIGN_EPI) { if (wr == 1) PG8_BAR; }
    }
    PG8_WAIT_V(0);
    if constexpr (!ALIGN_EPI) { if (wr == 0) PG8_BAR; }
    PG8_BAR;
    if constexpr (Epi::AFTER_DRAIN) { E.fused(acc, cur, wr, wc, fr, fq, lds, wid, lane); S.done(cur); }
#undef PG8_SA
#undef PG8_SB
#undef PG8_STAGE
#undef PG8_LDA
#undef PG8_LDB
#undef PG8_MMA
#undef PG8_WAIT_V
#undef PG8_WAIT_L
#undef PG8_BAR
#undef PG8_SCHED
}
}

#define LAS __attribute__((address_space(3)))
typedef pg8::bf16_t bf16_t;
typedef short bf16x8 __attribute__((ext_vector_type(8)));
typedef short s16x4 __attribute__((ext_vector_type(4)));
typedef float f32x4 __attribute__((ext_vector_type(4)));
typedef float f32x16 __attribute__((ext_vector_type(16)));
typedef unsigned u32x4 __attribute__((ext_vector_type(4)));
typedef unsigned u32x2 __attribute__((ext_vector_type(2)));

constexpr int DM = 1024, NBATCH = 16, SEQ = 2048, MROWS = NBATCH * SEQ, DFF = 2816, NUP = 2 * DFF, NQKV = 1536, NCIN = 3072, NADA = 9 * DM, DEPTH = 4;
constexpr int NWAVES = 8, NTHREADS = NWAVES * 64;
constexpr int LDS_BYTES = 131072 + 1024 + 4096;
constexpr size_t MiB = 1u << 20;
constexpr size_t WS_UP = 0, WS_DN = 88 * MiB, WS_QKV = 132 * MiB, WS_O = 138 * MiB, WS_CIN = 142 * MiB, WS_COUT = 154 * MiB;
constexpr size_t WS_MOD = 158 * MiB, WS_SB = 161 * MiB, WS_RS = 166 * MiB, WS_COS = 168 * MiB, WS_SIN = 172 * MiB, WS_GT = 176 * MiB, WS_GATE = 177 * MiB, WS_AP = 178 * MiB, WS_BIG = 242 * MiB, WS_XALT = 434 * MiB, WS_END = 562 * MiB;
constexpr size_t WS_PAR = 177 * MiB + 768 * 1024;
constexpr int PAR_BO = 0, PAR_QG = 2048, PAR_KG = 2176, PAR_SINK = 2304, PAR_CW = 2336, PAR_N = 2336 + 6144;
constexpr size_t WS_BARW = WS_PAR + 64 * 1024;
constexpr size_t SB_STRIDE = (size_t)16 * NUP;
constexpr int NPH = 2 + 7 * DEPTH;

struct Args { const void* in[18]; float* out; unsigned char* ws; int ph_lo, ph_hi; };

__device__ const float INVF[32] = {1.0f, 0.7498942613601685f, 0.5623413324356079f, 0.4216965138912201f, 0.3162277638912201f, 0.23713737726211548f, 0.17782793939113617f, 0.133352130651474f,
    0.10000000149011612f, 0.07498941570520401f, 0.05623413249850273f, 0.04216965287923813f, 0.03162277489900589f, 0.023713737726211548f, 0.017782794311642647f, 0.01333521492779255f,
    0.009999999776482582f, 0.007498941849917173f, 0.005623413249850273f, 0.0042169648222625256f, 0.003162277629598975f, 0.00237137358635664f, 0.0017782794311642647f, 0.0013335214462131262f,
    0.0010000000474974513f, 0.0007498942431993783f, 0.000562341301701963f, 0.0004216965171508491f, 0.0003162277571391314f, 0.00023713737027719617f, 0.00017782794020604342f, 0.0001333521504420787f};

#define LDS_WAIT() asm volatile("s_waitcnt lgkmcnt(0)" ::: "memory")
__device__ __forceinline__ unsigned f2bf(float f) { unsigned u = __builtin_bit_cast(unsigned, f); return (u + 0x7fffu + ((u >> 16) & 1u)) >> 16; }
__device__ __forceinline__ unsigned pk2(float lo, float hi) { return f2bf(lo) | (f2bf(hi) << 16); }
__device__ __forceinline__ float bf_lo(unsigned w) { return __builtin_bit_cast(float, w << 16); }
__device__ __forceinline__ float bf_hi(unsigned w) { return __builtin_bit_cast(float, w & 0xffff0000u); }
__device__ __forceinline__ float wave_sum(float v) {
#pragma unroll
    for (int o = 1; o < 64; o <<= 1) v += __shfl_xor(v, o);
    return v;
}

#define RLX_AGENT __ATOMIC_RELAXED, __HIP_MEMORY_SCOPE_AGENT
#define XB_TMO      128
#define XB_XCNT(j)  (256  + 64 * (j))
#define XB_XSUB(j)  (1280 + 64 * (j))
#define XB_XGEN(j)  (2304 + 64 * (j))
#define XB_TOP      3328
#define XB_TOPGEN   3392
#define XCD_BAR_WORDS 3456
#define XB_SPIN_CAP (1u << 18)

__device__ __forceinline__ unsigned xb_ld(unsigned* p)              { return __hip_atomic_load(p, __ATOMIC_RELAXED, __HIP_MEMORY_SCOPE_AGENT); }
__device__ __forceinline__ unsigned xb_add(unsigned* p, unsigned v) { return __hip_atomic_fetch_add(p, v, __ATOMIC_RELAXED, __HIP_MEMORY_SCOPE_AGENT); }
__device__ __forceinline__ unsigned xb_xcc_id() { return (unsigned)__builtin_amdgcn_s_getreg((3 << 11) | 20) & 0xFu; }
#define XB_SPIN(cond, bar) do { unsigned _sp = 0; while (cond) { __builtin_amdgcn_s_sleep(1); \
    if ((++_sp & 255u) == 0u) { if (xb_ld(&(bar)[XB_TMO])) break; if (_sp > XB_SPIN_CAP) { atomicAdd(&(bar)[XB_TMO], 1u); break; } } } } while (0)

struct XcdBarrier {
    unsigned* bar; unsigned x;
    volatile LAS unsigned* st;
};

__device__ __forceinline__ XcdBarrier xcd_barrier_post(unsigned* bar, volatile LAS unsigned* st) {
    XcdBarrier b; b.bar = bar; b.x = xb_xcc_id(); b.st = st;
    if (threadIdx.x == 0) (void)xb_add(&bar[XB_XCNT(b.x)], 1u);
    return b;
}
__device__ __forceinline__ void xcd_barrier_complete(unsigned* bar, unsigned x, unsigned& nloc, unsigned& nx) {
    const unsigned G = gridDim.x * gridDim.y * gridDim.z;
    unsigned sum, cnt, mine, sp = 0u;
    for (;;) {
        sum = 0u; cnt = 0u; mine = 0u;
#pragma unroll
        for (unsigned j = 0; j < 16; ++j) { const unsigned c = xb_ld(&bar[XB_XCNT(j)]); sum += c; cnt += (c > 0u) ? 1u : 0u; mine = (j == x) ? c : mine; }
        if (sum == G) break;
        __builtin_amdgcn_s_sleep(1);
        if ((++sp & 255u) == 0u) { if (xb_ld(&bar[XB_TMO])) break; if (sp > XB_SPIN_CAP) { atomicAdd(&bar[XB_TMO], 1u); break; } }
    }
    nloc = mine > 0u ? mine : 1u; nx = cnt > 0u ? cnt : 1u;
}

__device__ __forceinline__ void xcd_barrier(const XcdBarrier& b) {
    asm volatile("s_waitcnt vmcnt(0)" ::: "memory");
    __syncthreads();
    if (threadIdx.x == 0) {
        unsigned* bar = b.bar;
        __builtin_amdgcn_s_waitcnt(0);
        unsigned nloc = b.st[0], nx = b.st[1];
        if (nloc == 0u) { xcd_barrier_complete(bar, b.x, nloc, nx); b.st[0] = nloc; b.st[1] = nx; }
        const unsigned old = xb_add(&bar[XB_XSUB(b.x)], 1u);
        const unsigned gen = old / nloc;
        if (old + 1u == (gen + 1u) * nloc) {
            __builtin_amdgcn_fence(__ATOMIC_RELEASE, "agent");
            asm volatile("s_waitcnt vmcnt(0)" ::: "memory");
            const unsigned og = xb_add(&bar[XB_TOP], 1u);
            const unsigned tg = og / nx;
            if (og + 1u == (tg + 1u) * nx) xb_add(&bar[XB_TOPGEN], 1u);
            else XB_SPIN(xb_ld(&bar[XB_TOPGEN]) == tg, bar);
            __builtin_amdgcn_fence(__ATOMIC_ACQUIRE, "agent");
            xb_add(&bar[XB_XGEN(b.x)], 1u);
            asm volatile("s_waitcnt vmcnt(0)" ::: "memory");
        } else {
            XB_SPIN(xb_ld(&bar[XB_XGEN(b.x)]) == gen, bar);
            __builtin_amdgcn_fence(__ATOMIC_ACQUIRE, "agent");
            asm volatile("s_waitcnt vmcnt(0)" ::: "memory");
        }
    }
    __syncthreads();
}

__device__ __forceinline__ int srcblk(int mode, int nb) {
    const int pn = nb >> 3, q = nb & 7;
    if (mode == 0) return nb;
    if (mode == 1) return (q >> 2) * 88 + 4 * pn + (q & 3);
    if (mode == 2) return 8 * pn + 2 * (q & 3) + (q >> 2);
    return pn < 8 ? 32 * (1 + (q >> 2)) + 4 * pn + (q & 3) : 8 * (pn - 8) + q;
}
__device__ __forceinline__ void transpose_item(const float* W, int K, int N, bf16_t* WT, int mode, LAS float* scr, int item, int lane) {
    const int nblk = N / 32, kb = item / nblk, nb = item % nblk, k0 = 64 * kb, n0 = 32 * nb, s0 = 32 * srcblk(mode, nb);
    float wv[32];
    const float* wsrc = W + (size_t)(k0 + (lane >> 5)) * N + s0 + (lane & 31);
#pragma unroll
    for (int i = 0; i < 32; ++i) wv[i] = wsrc[(size_t)(2 * i) * N];
#pragma unroll
    for (int i = 0; i < 32; ++i) scr[(2 * i + (lane >> 5)) * 33 + (lane & 31)] = wv[i];
    LDS_WAIT(); asm volatile("" ::: "memory");
    const int c = lane & 7;
#pragma unroll
    for (int j = 0; j < 4; ++j) { const int n = (lane >> 3) + 8 * j; const LAS float* s = scr + (8 * c) * 33 + n;
        u32x4 o; o.x = pk2(s[0 * 33], s[1 * 33]); o.y = pk2(s[2 * 33], s[3 * 33]); o.z = pk2(s[4 * 33], s[5 * 33]); o.w = pk2(s[6 * 33], s[7 * 33]);
        *(u32x4*)(WT + (size_t)(n0 + n) * K + k0 + 8 * c) = o; }
    LDS_WAIT(); asm volatile("" ::: "memory");
}
constexpr int IT_UP = 8 * 2816, IT_DN = 8 * 1408, IT_QKV = 2 * 768, IT_O = 2 * 512, IT_CIN = 2 * 1536, IT_COUT = 2 * 512;
constexpr int NITEMS = IT_UP + IT_DN + IT_QKV + IT_O + IT_CIN + IT_COUT;
__device__ __forceinline__ void conv_item(const Args& a, int it, LAS float* scr, int lane) {
    unsigned char* ws = a.ws; int r = it;
    if (r < IT_UP) { const int i = r / 2816; r -= i * 2816; transpose_item((const float*)a.in[6] + (size_t)i * 1024 * NUP, 1024, NUP, (bf16_t*)(ws + WS_UP) + (size_t)i * NUP * 1024, 1, scr, r, lane); return; }
    r -= IT_UP;
    if (r < IT_DN) { const int i = r / 1408; r -= i * 1408; transpose_item((const float*)a.in[7] + (size_t)i * DFF * 1024, DFF, 1024, (bf16_t*)(ws + WS_DN) + (size_t)i * 1024 * DFF, 0, scr, r, lane); return; }
    r -= IT_DN;
    if (r < IT_QKV) { const int i = r / 768; r -= i * 768; transpose_item((const float*)a.in[8] + (size_t)i * 1024 * NQKV, 1024, NQKV, (bf16_t*)(ws + WS_QKV) + (size_t)i * NQKV * 1024, 2, scr, r, lane); return; }
    r -= IT_QKV;
    if (r < IT_O) { const int i = r / 512; r -= i * 512; transpose_item((const float*)a.in[13] + (size_t)i * 1024 * 1024, 1024, 1024, (bf16_t*)(ws + WS_O) + (size_t)i * 1024 * 1024, 0, scr, r, lane); return; }
    r -= IT_O;
    if (r < IT_CIN) { const int i = r / 1536; r -= i * 1536; transpose_item((const float*)a.in[15] + (size_t)i * 1024 * NCIN, 1024, NCIN, (bf16_t*)(ws + WS_CIN) + (size_t)i * NCIN * 1024, 3, scr, r, lane); return; }
    r -= IT_CIN;
    { const int i = r / 512; r -= i * 512; transpose_item((const float*)a.in[17] + (size_t)i * 1024 * 1024, 1024, 1024, (bf16_t*)(ws + WS_COUT) + (size_t)i * 1024 * 1024, 0, scr, r, lane); }
}

constexpr int GEMV_TASKS = DEPTH * (NADA / 256);
__device__ __forceinline__ void gemv_task(const Args& a, int task, LAS unsigned char* lds, int tid, int lane, int wid) {
    const float* c = (const float*)a.in[1]; const float* w_ada = (const float*)a.in[4]; const float* b_ada = (const float*)a.in[5];
    float* mod = (float*)(a.ws + WS_MOD);
    LAS float* cact = (LAS float*)lds;
    LAS float* red = (LAS float*)(lds + 65536);
    const int l = task / 36, n0 = (task % 36) * 256;
    __syncthreads();
    for (int i = 0; i < 32; ++i) { const int idx = tid + 512 * i, k = idx >> 4, b = idx & 15; const float v = c[b * 1024 + k]; cact[idx] = v / (1.f + __expf(-v)); }
    __syncthreads();
    float acc[64];
#pragma unroll
    for (int i = 0; i < 64; ++i) acc[i] = 0.f;
    const float* wp = w_ada + ((size_t)l * 1024 + wid * 128) * NADA + n0 + 4 * lane;
#pragma unroll 8
    for (int k = 0; k < 128; ++k) {
        const f32x4 wv = *(const f32x4*)(wp + (size_t)k * NADA);
        const LAS f32x4* cp = (const LAS f32x4*)(cact + (wid * 128 + k) * 16);
#pragma unroll
        for (int bq = 0; bq < 4; ++bq) { const f32x4 cb = cp[bq];
#pragma unroll
            for (int e = 0; e < 4; ++e)
#pragma unroll
                for (int j = 0; j < 4; ++j) acc[(bq * 4 + e) * 4 + j] += cb[e] * wv[j]; }
    }
#pragma unroll
    for (int r = 0; r < 2; ++r) {
#pragma unroll
        for (int q = 0; q < 32; ++q) red[(wid * 32 + q) * 64 + lane] = acc[32 * r + q];
        __syncthreads();
#pragma unroll
        for (int i = 0; i < 4; ++i) { const int idx = tid + 512 * i, q = idx >> 6, ln = idx & 63; float s = 0.f;
#pragma unroll
            for (int w = 0; w < 8; ++w) s += red[(w * 32 + q) * 64 + ln];
            const int A = 32 * r + q, bb = A >> 2, j = A & 3;
            mod[((size_t)l * 16 + bb) * NADA + n0 + 4 * ln + j] = s + b_ada[l * NADA + n0 + 4 * ln + j]; }
        __syncthreads();
    }
}

__device__ __forceinline__ void sincos_acc(float angf, float& co, float& si) {
    const double a = (double)angf;
    const double qd = __builtin_rint(a * 0.63661977236758134308);
    const double r = __builtin_fma(-qd, 1.57079632679489661923, a), r2 = r * r;
    double sp = 1.0 / 6227020800.0; sp = sp * r2 - 1.0 / 39916800.0; sp = sp * r2 + 1.0 / 362880.0; sp = sp * r2 - 1.0 / 5040.0; sp = sp * r2 + 1.0 / 120.0; sp = sp * r2 - 1.0 / 6.0; sp = sp * r2 + 1.0; sp = sp * r;
    double cp = 1.0 / 479001600.0; cp = cp * r2 - 1.0 / 3628800.0; cp = cp * r2 + 1.0 / 40320.0; cp = cp * r2 - 1.0 / 720.0; cp = cp * r2 + 1.0 / 24.0; cp = cp * r2 - 0.5; cp = cp * r2 + 1.0;
    const int q = ((int)qd) & 3;
    const double s = (q == 0) ? sp : (q == 1) ? cp : (q == 2) ? -sp : -cp;
    const double cc = (q == 0) ? cp : (q == 1) ? -sp : (q == 2) ? -cp : sp;
    co = (float)cc; si = (float)s;
}

__device__ __forceinline__ void p0a(const Args& a, LAS unsigned char* lds, int tid, int lane, int wid) {
    const int G = gridDim.x, bx = blockIdx.x;
    int ngemv = G < GEMV_TASKS ? G : GEMV_TASKS;
    constexpr int XSPLIT = 8960;
    if (bx < ngemv) { for (int t = bx; t < GEMV_TASKS; t += ngemv) gemv_task(a, t, lds, tid, lane, wid); __syncthreads(); }
    LAS float* scr = (LAS float*)(lds + wid * 16384);
    int xs = 0;
    if (G > ngemv) { xs = XSPLIT; if (bx >= ngemv) { const int nw = (G - ngemv) * NWAVES; for (int it = (bx - ngemv) * NWAVES + wid; it < xs; it += nw) conv_item(a, it, scr, lane); } }
    { const int nw = G * NWAVES; for (int it = xs + bx * NWAVES + wid; it < NITEMS; it += nw) conv_item(a, it, scr, lane); }
    if (bx == 0) { unsigned* bw = (unsigned*)(a.ws + WS_BARW); for (int i = tid; i < XCD_BAR_WORDS; i += NTHREADS) bw[i] = 0u; }
    const int gt = bx * NTHREADS + tid, nt = G * NTHREADS;
    const int* pos = (const int*)a.in[2]; float* cosT = (float*)(a.ws + WS_COS); float* sinT = (float*)(a.ws + WS_SIN);
    for (int idx = gt; idx < MROWS * 32; idx += nt) { const int row = idx >> 5, p = idx & 31; const float ang = (float)pos[row] * INVF[p]; float co, si; sincos_acc(ang, co, si); cosT[idx] = co; sinT[idx] = si; }
}

constexpr int SB_TASKS = (8 * NUP + 2 * NQKV + 2 * NCIN) / 16;
__device__ __forceinline__ void sb_task(const Args& a, int task, int lane) {
    int s = 0, r = task, N = NUP;
    for (s = 0; s < 12; ++s) { const int l = s / 3, j = s % 3; N = (j != 1) ? NUP : ((l & 1) ? NCIN : NQKV); if (r < N / 16) break; r -= N / 16; }
    const int l = s / 3, j = s % 3;
    const bf16_t* Bt;
    if (j == 0) Bt = (const bf16_t*)(a.ws + WS_UP) + (size_t)(2 * l) * NUP * 1024;
    else if (j == 2) Bt = (const bf16_t*)(a.ws + WS_UP) + (size_t)(2 * l + 1) * NUP * 1024;
    else if (l & 1) Bt = (const bf16_t*)(a.ws + WS_CIN) + (size_t)(l >> 1) * NCIN * 1024;
    else Bt = (const bf16_t*)(a.ws + WS_QKV) + (size_t)(l >> 1) * NQKV * 1024;
    const float* shift = (const float*)(a.ws + WS_MOD) + (size_t)l * 16 * NADA + 3 * j * 1024;
    float* sb = (float*)(a.ws + WS_SB) + (size_t)s * SB_STRIDE;
    const int n0 = 16 * r, i16 = lane & 15, kq = lane >> 4;
    const bf16_t* bp = Bt + (size_t)(n0 + i16) * 1024 + 8 * kq;
    const float* sp = shift + (size_t)i16 * NADA + 8 * kq;
    f32x4 c = {0.f, 0.f, 0.f, 0.f};
#pragma unroll 8
    for (int kk = 0; kk < 32; ++kk) {
        const bf16x8 wb = *(const bf16x8*)(bp + 32 * kk);
        const f32x4 s0 = *(const f32x4*)(sp + 32 * kk), s1 = *(const f32x4*)(sp + 32 * kk + 4);
        u32x4 w; w.x = pk2(s0[0], s0[1]); w.y = pk2(s0[2], s0[3]); w.z = pk2(s1[0], s1[1]); w.w = pk2(s1[2], s1[3]);
        c = __builtin_amdgcn_mfma_f32_16x16x32_bf16(wb, __builtin_bit_cast(bf16x8, w), c, 0, 0, 0);
    }
    const int n = n0 + 4 * kq;
    if (j == 1 && !(l & 1)) { const int pn = n >> 8, q = (n >> 5) & 7, src = 256 * pn + 64 * (q & 3) + 32 * (q >> 2) + (n & 31);
        const f32x4 bv = *(const f32x4*)((const float*)a.in[9] + (size_t)(l >> 1) * NQKV + src); c = c + bv; }
    *(f32x4*)(sb + (size_t)i16 * N + n) = c;
}
__device__ __forceinline__ void p0b(const Args& a, int tid, int lane, int wid) {
    const int gw = blockIdx.x * NWAVES + wid, NGW = gridDim.x * NWAVES;
    for (int t = gw; t < SB_TASKS; t += NGW) sb_task(a, t, lane);
    const float* x = (const float*)a.in[0]; const float* gain = (const float*)a.in[3]; const float* mod = (const float*)(a.ws + WS_MOD);
    { float* par = (float*)(a.ws + WS_PAR);
      for (int idx = blockIdx.x * NTHREADS + tid; idx < PAR_N; idx += gridDim.x * NTHREADS) { float v;
          if (idx < PAR_QG) v = ((const float*)a.in[14])[idx]; else if (idx < PAR_KG) v = ((const float*)a.in[10])[idx - PAR_QG]; else if (idx < PAR_SINK) v = ((const float*)a.in[11])[idx - PAR_KG];
          else if (idx < PAR_CW) v = ((const float*)a.in[12])[idx - PAR_SINK]; else v = ((const float*)a.in[16])[idx - PAR_CW];
          par[idx] = v; } }
    { float* GT = (float*)(a.ws + WS_GT); float* GATE = (float*)(a.ws + WS_GATE);
      for (int idx = blockIdx.x * NTHREADS + tid; idx < 12 * 16 * 1024; idx += gridDim.x * NTHREADS) { const int s = idx >> 14, b = (idx >> 10) & 15, k = idx & 1023, l = s / 3, j = s % 3;
          const float* m = mod + ((size_t)l * 16 + b) * NADA + 3 * j * 1024; GT[idx] = gain[s * 1024 + k] * (1.0f + m[1024 + k]); GATE[idx] = (j == 1 ? 1.0f : 0.5f) * m[2048 + k]; } }
    bf16_t* AP = (bf16_t*)(a.ws + WS_AP); float* rs = (float*)(a.ws + WS_RS);
    for (int row = gw; row < MROWS; row += NGW) {
        const int b = row >> 11; const float* xr = x + (size_t)row * 1024 + 4 * lane; const float* sc = mod + (size_t)b * NADA + 1024 + 4 * lane;
        f32x4 v[4]; float ss = 0.f;
#pragma unroll
        for (int j = 0; j < 4; ++j) { v[j] = *(const f32x4*)(xr + 256 * j); ss += (v[j][0] * v[j][0] + v[j][1] * v[j][1]) + (v[j][2] * v[j][2] + v[j][3] * v[j][3]); }
        ss = wave_sum(ss);
        if (lane < 4) *(f32x4*)(rs + (size_t)row * 16 + 4 * lane) = (f32x4){lane == 0 ? ss : 0.f, 0.f, 0.f, 0.f};
#pragma unroll
        for (int j = 0; j < 4; ++j) { const f32x4 g = *(const f32x4*)(gain + 4 * lane + 256 * j) * (*(const f32x4*)(sc + 256 * j) + 1.0f); const f32x4 o = v[j] * g;
            u32x2 w; w.x = pk2(o[0], o[1]); w.y = pk2(o[2], o[3]); *(u32x2*)(AP + (size_t)row * 1024 + 4 * lane + 256 * j) = w; }
    }
}

constexpr int ATT_KS = 144, ATT_VS = 260, ATT_VOFF = 256 * ATT_KS;
__device__ __forceinline__ void attn_phase(LAS unsigned char* lds, const bf16_t* Q, const bf16_t* K, const bf16_t* V, bf16_t* O, const float* sinks, int tid, int lane, int wid, int u_first, int u_end, int u_step) {
    const int q32 = lane & 31, hi = lane >> 5;
    const float NEG = -__builtin_inff();
    for (int unit = u_first; unit < u_end; unit += u_step) {
        const int qb = unit & 15, kvh = (unit >> 4) & 3, b = unit >> 6;
        const size_t rowbase = (size_t)b * SEQ; const int kstart = (qb - 1) * 128;
        __syncthreads();
#pragma unroll
        for (int i = 0; i < 4; ++i) { const int idx = tid + 512 * i, row = idx >> 3, ch = idx & 7, kr = kstart + row;
            u32x4 kv = {0u, 0u, 0u, 0u}, vv = {0u, 0u, 0u, 0u};
            if (kr >= 0) { kv = *(const u32x4*)(K + (rowbase + kr) * 256 + kvh * 64 + ch * 8); vv = *(const u32x4*)(V + (rowbase + kr) * 256 + kvh * 64 + ch * 8); }
            *(LAS u32x4*)(lds + row * ATT_KS + ch * 16) = kv;
            LAS bf16_t* vt = (LAS bf16_t*)(lds + ATT_VOFF) + (ch * 8) * ATT_VS + row;
#pragma unroll
            for (int e = 0; e < 8; ++e) vt[e * ATT_VS] = (bf16_t)((vv[e >> 1] >> (16 * (e & 1))) & 0xffffu);
        }
        __syncthreads();
        const int head = kvh * 4 + (wid >> 1), h2 = wid & 1;
        const float sink2 = sinks[head] * 1.44269504f;
#pragma unroll 1
        for (int qi = 0; qi < 2; ++qi) {
            const int qo = 64 * h2 + 32 * qi, kt0 = qo >> 5;
            const size_t qrow = rowbase + qb * 128 + qo + q32;
            bf16x8 qr[4];
#pragma unroll
            for (int ks = 0; ks < 4; ++ks) qr[ks] = *(const bf16x8*)(Q + qrow * 1024 + head * 64 + ks * 16 + hi * 8);
            f32x16 s[5];
#pragma unroll
            for (int j = 0; j < 5; ++j) {
                const int kt = kt0 + j;
                f32x16 acc = {0.f, 0.f, 0.f, 0.f, 0.f, 0.f, 0.f, 0.f, 0.f, 0.f, 0.f, 0.f, 0.f, 0.f, 0.f, 0.f};
#pragma unroll
                for (int ks = 0; ks < 4; ++ks) { const bf16x8 ka = *(const LAS bf16x8*)(lds + (32 * kt + q32) * ATT_KS + ks * 32 + hi * 16);
                    acc = __builtin_amdgcn_mfma_f32_32x32x16_bf16(ka, qr[ks], acc, 0, 0, 0); }
                const bool dead = (qb == 0) && (kt < 4);
#pragma unroll
                for (int r = 0; r < 16; ++r) { const int key = (r & 3) + 8 * (r >> 2) + 4 * hi;
                    bool ok = !dead;
                    if (j == 0) ok = ok && (q32 < key);
                    if (j == 4) ok = ok && (key <= q32);
                    acc[r] = ok ? acc[r] : NEG; }
                s[j] = acc;
            }
            float mx = sink2;
#pragma unroll
            for (int j = 0; j < 5; ++j)
#pragma unroll
                for (int r = 0; r < 16; ++r) mx = fmaxf(mx, s[j][r]);
            mx = fmaxf(mx, __shfl_xor(mx, 32));
            float l = 0.f;
#pragma unroll
            for (int j = 0; j < 5; ++j)
#pragma unroll
                for (int r = 0; r < 16; ++r) { const float p = __builtin_amdgcn_exp2f(s[j][r] - mx); s[j][r] = p; l += p; }
            l += __shfl_xor(l, 32);
            l += __builtin_amdgcn_exp2f(sink2 - mx);
            f32x16 o[2];
#pragma unroll
            for (int db = 0; db < 2; ++db) o[db] = (f32x16){0.f, 0.f, 0.f, 0.f, 0.f, 0.f, 0.f, 0.f, 0.f, 0.f, 0.f, 0.f, 0.f, 0.f, 0.f, 0.f};
#pragma unroll
            for (int j = 0; j < 5; ++j) {
                const int kt = kt0 + j;
#pragma unroll
                for (int st = 0; st < 2; ++st) {
                    u32x4 pw; pw.x = pg8::cvt_pk_bf16(s[j][8 * st + 0], s[j][8 * st + 1]); pw.y = pg8::cvt_pk_bf16(s[j][8 * st + 2], s[j][8 * st + 3]);
                    pw.z = pg8::cvt_pk_bf16(s[j][8 * st + 4], s[j][8 * st + 5]); pw.w = pg8::cvt_pk_bf16(s[j][8 * st + 6], s[j][8 * st + 7]);
                    const bf16x8 pb = __builtin_bit_cast(bf16x8, pw);
#pragma unroll
                    for (int db = 0; db < 2; ++db) {
                        const LAS unsigned char* vp = lds + ATT_VOFF + ((q32 + 32 * db) * ATT_VS + 32 * kt + 16 * st + 4 * hi) * 2;
                        const s16x4 lo = *(const LAS s16x4*)(vp), hh = *(const LAS s16x4*)(vp + 16);
                        const bf16x8 va = {lo[0], lo[1], lo[2], lo[3], hh[0], hh[1], hh[2], hh[3]};
                        o[db] = __builtin_amdgcn_mfma_f32_32x32x16_bf16(va, pb, o[db], 0, 0, 0);
                    }
                }
            }
            const float inv = 1.0f / l;
            bf16_t* op = O + qrow * 1024 + head * 64 + 4 * hi;
#pragma unroll
            for (int db = 0; db < 2; ++db)
#pragma unroll
                for (int rq = 0; rq < 4; ++rq) { u32x2 w; w.x = pg8::cvt_pk_bf16(o[db][4 * rq] * inv, o[db][4 * rq + 1] * inv); w.y = pg8::cvt_pk_bf16(o[db][4 * rq + 2] * inv, o[db][4 * rq + 3] * inv);
                    *(u32x2*)(op + 32 * db + 8 * rq) = w; }
        }
    }
}

__device__ __forceinline__ void unpack8(u32x4 w, float (&f)[8]) {
#pragma unroll
    for (int i = 0; i < 4; ++i) { f[2 * i] = bf_lo(w[i]); f[2 * i + 1] = bf_hi(w[i]); }
}
__device__ __forceinline__ void conv_phase(const bf16_t* U, const bf16_t* GB, bf16_t* A2, const float* cw, int tid, int t_first, int t_end, int t_step) {
    const int c8 = (tid & 127) * 8, chunk = tid >> 7;
    float w0[8], w1[8], w2[8];
#pragma unroll
    for (int e = 0; e < 8; ++e) { w0[e] = cw[c8 + e]; w1[e] = cw[1024 + c8 + e]; w2[e] = cw[2048 + c8 + e]; }
    for (int task = t_first; task < t_end; task += t_step) {
        const int rstart = task * 64 + chunk * 16, t0 = rstart & (SEQ - 1);
        float um2[8], um1[8];
        if (t0 > 0) { unpack8(*(const u32x4*)(U + (size_t)(rstart - 2) * 1024 + c8), um2); unpack8(*(const u32x4*)(U + (size_t)(rstart - 1) * 1024 + c8), um1); }
        else {
#pragma unroll
            for (int e = 0; e < 8; ++e) { um2[e] = 0.f; um1[e] = 0.f; } }
#pragma unroll 4
        for (int i = 0; i < 16; ++i) {
            const size_t off = (size_t)(rstart + i) * 1024 + c8;
            float uc[8], g[8], y[8]; unpack8(*(const u32x4*)(U + off), uc); unpack8(*(const u32x4*)(GB + off), g);
#pragma unroll
            for (int e = 0; e < 8; ++e) { y[e] = g[e] * (w0[e] * um2[e] + w1[e] * um1[e] + w2[e] * uc[e]); um2[e] = um1[e]; um1[e] = uc[e]; }
            u32x4 w; w.x = pk2(y[0], y[1]); w.y = pk2(y[2], y[3]); w.z = pk2(y[4], y[5]); w.w = pk2(y[6], y[7]);
            *(u32x4*)(A2 + off) = w;
        }
    }
}

__device__ __forceinline__ void xcc_barrier(unsigned* bar, unsigned x, unsigned nloc) {
    asm volatile("s_waitcnt vmcnt(0)" ::: "memory");
    __syncthreads();
    if (threadIdx.x == 0) {
        __builtin_amdgcn_s_waitcnt(0);
        const unsigned old = xb_add(&bar[XB_XSUB(x)], 1u);
        const unsigned gen = old / nloc;
        if (old + 1u == (gen + 1u) * nloc) xb_add(&bar[XB_XGEN(x)], 1u);
        else XB_SPIN(xb_ld(&bar[XB_XGEN(x)]) == gen, bar);
        __builtin_amdgcn_fence(__ATOMIC_ACQUIRE, "agent");
        asm volatile("s_waitcnt vmcnt(0)" ::: "memory");
    }
    __syncthreads();
}

__device__ __forceinline__ void grid_seam() {
    asm volatile("s_waitcnt vmcnt(0) lgkmcnt(0)" ::: "memory");
    __syncthreads();
    cg::this_grid().sync();
    __builtin_amdgcn_fence(__ATOMIC_ACQUIRE, "agent");
    asm volatile("s_waitcnt vmcnt(0)" ::: "memory");
}
#ifndef MK_MULTI
#define MK_MULTI 0
#endif
#ifndef LAYER_STEPS
#define LAYER_STEPS {0, 1, 2, 3, 4, 5, 6}
#endif
__device__ const int LSTEP[] = LAYER_STEPS;
constexpr int NLS = sizeof(LSTEP) / sizeof(int);
#ifndef REP_PRO
#define REP_PRO 1
#endif
#ifndef REP_P0B
#define REP_P0B 1
#endif
__global__ void __launch_bounds__(NTHREADS, 2) mk_fwd(Args a) {
    extern __shared__ __attribute__((aligned(16))) unsigned char lds_raw[];
    LAS unsigned char* lds = (LAS unsigned char*)lds_raw;
    unsigned char* ws = a.ws;
    volatile LAS unsigned* bst = (volatile LAS unsigned*)(lds + 131072 + 512);
    if (threadIdx.x == 0) { bst[0] = 0u; bst[1] = 0u; }
    __syncthreads();
    {
        int tid = threadIdx.x; asm volatile("" : "+v"(tid)); const int lane = tid & 63, wid = __builtin_amdgcn_readfirstlane(tid >> 6);
#ifndef NO_P0A
        for (int rep = 0; rep < REP_PRO; ++rep) { p0a(a, lds, tid, lane, wid); __syncthreads(); }
#endif
        grid_seam();
    }
    if (threadIdx.x == 0) bst[2] = xb_add((unsigned*)(ws + WS_BARW) + XB_XCNT(xb_xcc_id()), 1u);
#define XBAR() do { XcdBarrier xb_; xb_.bar = (unsigned*)(ws + WS_BARW); xb_.x = xb_xcc_id(); xb_.st = bst; xcd_barrier(xb_); } while (0)
    {
        int tid = threadIdx.x; asm volatile("" : "+v"(tid)); const int lane = tid & 63, wid = __builtin_amdgcn_readfirstlane(tid >> 6);
#ifndef NO_P0B
        for (int rep = 0; rep < REP_P0B; ++rep) p0b(a, tid, lane, wid);
#endif
        XBAR();
    }
    if (threadIdx.x == 0) { unsigned* bw = (unsigned*)(ws + WS_BARW); bool reg = (gridDim.x == 256u);
        for (unsigned j = 0; j < 8; ++j) reg = reg && (xb_ld(&bw[XB_XCNT(j)]) == 32u);
#ifdef FORCE_GLOBAL
        reg = false;
#endif
        const unsigned x = xb_xcc_id();
        bst[3] = reg ? 1u : 0u; bst[4] = reg ? bst[2] * 8u + x : (unsigned)blockIdx.x; bst[5] = x; }
    __syncthreads();
    const float* xin = (const float*)a.in[0]; float* const outp = a.out;
    for (int it = 0; it < DEPTH * NLS; ++it) {
        unsigned char* ws = a.ws; asm volatile("" : "+s"(ws));
#define SLAB_EL ((size_t)12 * MiB)
#define TBASE(off_el, pitch, flat_el) (BST(3) ? BIG + (size_t)BST(5) * SLAB_EL + (size_t)(off_el) - (size_t)BST(5) * 4096 * (pitch) : BIG + (size_t)(flat_el))
#define T_ACT TBASE(0, DFF, 0)
#define T_Q   TBASE(0, 1024, 0)
#define T_K   TBASE(4 * MiB, 256, 32 * MiB)
#define T_V   TBASE(5 * MiB, 256, 40 * MiB)
#define T_ATT TBASE(6 * MiB, 1024, 48 * MiB)
#define T_U   TBASE(0, 1024, 0)
#define T_GB  TBASE(4 * MiB, 1024, (size_t)MROWS * 1024)
#define T_A2  TBASE(8 * MiB, 1024, (size_t)2 * MROWS * 1024)
#define BST(i) __builtin_amdgcn_readfirstlane((int)bst[i])
        float* rs = (float*)(ws + WS_RS); const float* sbt = (const float*)(ws + WS_SB);
        bf16_t* AP = (bf16_t*)(ws + WS_AP); bf16_t* BIG = (bf16_t*)(ws + WS_BIG);
        const float* GT = (const float*)(ws + WS_GT); const float* GATE = (const float*)(ws + WS_GATE);
        const float* par = (const float*)(ws + WS_PAR);
        int tid = threadIdx.x; asm volatile("" : "+v"(tid));
        const int lane = tid & 63, wid = __builtin_amdgcn_readfirstlane(tid >> 6);
        {
            const int l = it / NLS, k = LSTEP[it % NLS], s0 = 3 * l, jx = l >> 1;
            if (k == 0 || k == 5) {
                const int i = (k == 5), s = s0 + 2 * i;
                pg8::Gemm g{AP, (const bf16_t*)(ws + WS_UP) + (size_t)(2 * l + i) * NUP * 1024, MROWS, NUP, 1024};
                pg8::StaticOrder S; S.init(MROWS, NUP, gridDim.x, BST(4));
                pg8::EpiUp E{T_ACT, rs, sbt + (size_t)s * SB_STRIDE, (LAS float*)(lds + 131072 + 1024), -1};
                #ifndef NO_UP
                pg8::gemm_phase<pg8::EpiUp, pg8::StaticOrder, true, true>(lds, g, S, E, tid);
#endif
            } else if (k == 1 || k == 6 || k == 4) {
                pg8::Gemm g; pg8::EpiResid E;
                const int ridx = 3 * l + (k == 1 ? 0 : (k == 4 ? 1 : 2));
                bf16_t* const xs0 = (bf16_t*)(ws + WS_XALT); bf16_t* const xs1 = xs0 + (size_t)MROWS * 1024;
                E.out_f32 = (ridx == 3 * DEPTH - 1); E.base_f32 = (ridx == 0);
                E.out = E.out_f32 ? (void*)outp : (void*)((ridx & 1) ? xs1 : xs0); E.base = E.base_f32 ? (const void*)xin : (const void*)((ridx & 1) ? xs0 : xs1); E.AP = AP; E.bias = nullptr;
                if (k == 4) {
                    g = pg8::Gemm{(l & 1) ? T_A2 : T_ATT, (l & 1) ? (const bf16_t*)(ws + WS_COUT) + (size_t)jx * 1024 * 1024 : (const bf16_t*)(ws + WS_O) + (size_t)jx * 1024 * 1024, MROWS, 1024, 1024};
                    E.gate = GATE + (s0 + 1) * 16384; if (!(l & 1)) E.bias = par + PAR_BO + jx * 1024;
                    E.Gn = GT + (s0 + 2) * 16384; E.nrowss = rs;
                } else {
                    const int i = (k == 6);
                    g = pg8::Gemm{T_ACT, (const bf16_t*)(ws + WS_DN) + (size_t)(2 * l + i) * 1024 * DFF, MROWS, 1024, DFF};
                    E.gate = GATE + (s0 + 2 * i) * 16384;
                    if (!i) { E.Gn = GT + (s0 + 1) * 16384; E.nrowss = rs; }
                    else if (l < DEPTH - 1) { E.Gn = GT + (s0 + 3) * 16384; E.nrowss = rs; }
                    else { E.AP = nullptr; E.Gn = GT; E.nrowss = rs; }
                }
                pg8::StaticOrder S; S.init(MROWS, 1024, gridDim.x, BST(4));
                #ifndef NO_RES
                pg8::gemm_phase<pg8::EpiResid, pg8::StaticOrder, true, true>(lds, g, S, E, tid);
#endif
            } else if (k == 2) {
                if (!(l & 1)) {
                    pg8::Gemm g{AP, (const bf16_t*)(ws + WS_QKV) + (size_t)jx * NQKV * 1024, MROWS, NQKV, 1024};
                    pg8::StaticOrder S; S.init(MROWS, NQKV, gridDim.x, BST(4));
                    pg8::EpiQKV E{T_Q, T_K, T_V, rs, sbt + (size_t)(s0 + 1) * SB_STRIDE,
                                  par + PAR_QG + jx * 64, par + PAR_KG + jx * 64, (const float*)(ws + WS_COS), (const float*)(ws + WS_SIN)};
                    #ifndef NO_QKV
                    pg8::gemm_phase<pg8::EpiQKV, pg8::StaticOrder, true, true>(lds, g, S, E, tid);
#endif
                } else {
                    pg8::Gemm g{AP, (const bf16_t*)(ws + WS_CIN) + (size_t)jx * NCIN * 1024, MROWS, NCIN, 1024};
                    pg8::StaticOrder S; S.init(MROWS, NCIN, gridDim.x, BST(4));
                    pg8::EpiCin E{T_U, T_GB, rs, sbt + (size_t)(s0 + 1) * SB_STRIDE};
                    #ifndef NO_CIN
                    pg8::gemm_phase<pg8::EpiCin, pg8::StaticOrder, true, true>(lds, g, S, E, tid);
#endif
                }
            } else {
#ifndef NO_ATT
                if (!(l & 1)) attn_phase(lds, T_Q, T_K, T_V, T_ATT, par + PAR_SINK + jx * 16, tid, lane, wid, BST(3) ? BST(5) * 128 + (BST(4) >> 3) : (int)blockIdx.x, BST(3) ? BST(5) * 128 + 128 : NBATCH * 64, BST(3) ? 32 : (int)gridDim.x);
                else
#endif
#ifndef NO_CONV
                conv_phase(T_U, T_GB, T_A2, par + PAR_CW + jx * 3 * 1024, tid, BST(3) ? BST(5) * 64 + (BST(4) >> 3) : (int)blockIdx.x, BST(3) ? BST(5) * 64 + 64 : MROWS / 64, BST(3) ? 32 : (int)gridDim.x);
#endif
                ;
            }
        }
        if (it + 1 < DEPTH * NLS) { unsigned char* ws = a.ws; asm volatile("" : "+s"(ws));
            if (__builtin_amdgcn_readfirstlane((int)bst[3])) xcc_barrier((unsigned*)(ws + WS_BARW), (unsigned)__builtin_amdgcn_readfirstlane((int)bst[5]), 32u); else XBAR();
#ifdef DOUBLE_SEAM
            XBAR(); XBAR();
#endif
        }
    }
}

extern "C" void kernel_launch(void* const* d_in, const int* in_sizes, int n_in, void* d_out, int out_size, void* d_ws, size_t ws_size, hipStream_t stream) {
    static int grid = 0;
    if (grid == 0) {
        if (n_in != 18 || out_size != MROWS * DM || ws_size < WS_END) { fprintf(stderr, "kernel_launch: unexpected problem (n_in %d, out %d, ws %zu); nothing launched\n", n_in, out_size, ws_size); grid = -1; return; }
        int dev = 0, cus = 0, per_cu = 0;
        if (hipGetDevice(&dev) != hipSuccess || hipDeviceGetAttribute(&cus, hipDeviceAttributeMultiprocessorCount, dev) != hipSuccess) { grid = -1; return; }
        if (hipFuncSetAttribute((const void*)mk_fwd, hipFuncAttributeMaxDynamicSharedMemorySize, LDS_BYTES) != hipSuccess) { fprintf(stderr, "kernel_launch: hipFuncSetAttribute failed\n"); grid = -1; return; }
        if (hipOccupancyMaxActiveBlocksPerMultiprocessor(&per_cu, (const void*)mk_fwd, NTHREADS, LDS_BYTES) != hipSuccess || per_cu < 1) { fprintf(stderr, "kernel_launch: occupancy query says %d\n", per_cu); per_cu = 1; }
        (void)hipGetLastError();
        grid = cus * per_cu;
    }
    if (grid < 0) return;
    Args a{};
    for (int i = 0; i < 18; ++i) a.in[i] = d_in[i];
    a.out = (float*)d_out; a.ws = (unsigned char*)d_ws;
#if MK_MULTI
    for (int ph = 0; ph < NPH; ++ph) { a.ph_lo = ph; a.ph_hi = ph + 1; hipLaunchKernelGGL(mk_fwd, dim3(grid), dim3(NTHREADS), LDS_BYTES, stream, a); }
#else
    a.ph_lo = 0; a.ph_hi = NPH;
    void* args[] = {&a};
    hipError_t e = hipLaunchCooperativeKernel((const void*)mk_fwd, dim3(grid), dim3(NTHREADS), args, LDS_BYTES, stream);
    if (e != hipSuccess) fprintf(stderr, "cooperative launch failed: %s (grid %d)\n", hipGetErrorString(e), grid);
#endif
}
```

```cpp
#include <hip/hip_runtime.h>
#include <hip/hip_cooperative_groups.h>
#include <cstdio>
#include <cstdint>
namespace cg = cooperative_groups;
namespace pg8 {
#define PG8_LAS __attribute__((address_space(3)))
typedef unsigned short bf16_t;
typedef short bf16x8 __attribute__((ext_vector_type(8)));
typedef float f32x4 __attribute__((ext_vector_type(4)));
typedef unsigned u32x4 __attribute__((ext_vector_type(4)));
constexpr int BM = 256, BK = 64, HALF = 128, HTB = HALF * BK * 2  , STAGE_BYTES = 8 * HTB, NXCD = 8, WGM = 8;

__host__ __device__ __forceinline__ int lds_byte(int r, int c) { const int st = (r >> 4) * 2 + (c >> 5), rr = r & 15, cc = c & 31, ob = rr * 64 + cc * 2; return st * 1024 + (ob ^ (((ob >> 9) & 1) << 5)); }
__host__ __device__ __forceinline__ void stage_rc(int b, int& R, int& C) { const int st = b / 1024, sb = b % 1024, swz = sb ^ (((sb >> 9) & 1) << 5); R = (st >> 1) * 16 + swz / 64; C = (st & 1) * 32 + (swz % 64) / 2; }
__host__ __device__ __forceinline__ int perm32(int rho) { const int n = rho >> 4, i = rho & 15; return 8 * (i >> 2) + 4 * n + (i & 3); }

struct Unit { int pm, pn; };
struct Gemm { const bf16_t* A; const bf16_t* Bt; int M, N, K; };

struct StaticOrder {
    int nM, nN, nwg, G, c;
    __host__ __device__ void init(int M, int N, int G_, int c_) { nM = M / BM; nN = N / BM; nwg = nM * nN; G = G_; c = c_; }
    __host__ __device__ bool next(int i, Unit& u) const {
        const long L = (long)i * G + c; if (L >= nwg) return false;
        int wgid = (int)L; { const int q = nwg / NXCD, r = nwg % NXCD, xcd = wgid % NXCD, off = wgid / NXCD; wgid = (xcd < r ? xcd * (q + 1) : r * (q + 1) + (xcd - r) * q) + off; }
        const int nig = WGM * nN, gid = wgid / nig, fm = gid * WGM, gsz = (nM - fm) < WGM ? (nM - fm) : WGM;
        u.pm = fm + ((wgid % nig) % gsz); u.pn = (wgid % nig) / gsz; return true;
    }
    __device__ __forceinline__ void a_ready(const Unit&) const {}
    __device__ __forceinline__ void done(const Unit&) const {}
};

typedef float f32x2 __attribute__((ext_vector_type(2)));
typedef __bf16 bf16x2_t __attribute__((ext_vector_type(2)));
__device__ __forceinline__ unsigned cvt_pk_bf16(float lo, float hi) { const f32x2 v = {lo, hi}; const bf16x2_t b = __builtin_convertvector(v, bf16x2_t); return __builtin_bit_cast(unsigned, b); }
typedef unsigned u32x2 __attribute__((ext_vector_type(2)));
#define PG8_GAS __attribute__((address_space(1)))
__device__ __forceinline__ f32x4 ld4(const float* p) { return *(const PG8_GAS f32x4*)p; }
__device__ __forceinline__ u32x4 ld4u(const void* p) { return *(const PG8_GAS u32x4*)p; }
__device__ __forceinline__ void st4f(float* p, f32x4 v) { *(PG8_GAS f32x4*)p = v; }
__device__ __forceinline__ void st4u(void* p, u32x4 v) { *(PG8_GAS u32x4*)p = v; }
__device__ __forceinline__ u32x4 pack8(f32x4 a, f32x4 b) { u32x4 w; w.x = cvt_pk_bf16(a[0], a[1]); w.y = cvt_pk_bf16(a[2], a[3]); w.z = cvt_pk_bf16(b[0], b[1]); w.w = cvt_pk_bf16(b[2], b[3]); return w; }
__device__ __forceinline__ float silu_f(float g) { return g * __builtin_amdgcn_rcpf(1.f + __builtin_amdgcn_exp2f(-1.44269504f * g)); }
__device__ __forceinline__ float rstd_of(float ss, float inv_n) { return 1.0f / sqrtf(ss * inv_n + 1e-6f); }
__device__ __forceinline__ float rstd_row(const float* rsp, int row) {
    const f32x4 a = ld4(rsp + (size_t)row * 16), b = ld4(rsp + (size_t)row * 16 + 4), c = ld4(rsp + (size_t)row * 16 + 8), d = ld4(rsp + (size_t)row * 16 + 12);
    const float s = (((a[0] + a[1]) + (a[2] + a[3])) + ((b[0] + b[1]) + (b[2] + b[3]))) + (((c[0] + c[1]) + (c[2] + c[3])) + ((d[0] + d[1]) + (d[2] + d[3])));
    return rstd_of(s, 1.f / 1024.f);
}

__device__ __forceinline__ void rstd8(const float* rsp, int row0, int fq, float (&r)[2][4]) {
    f32x4 p[2][4];
#pragma unroll
    for (int ai = 0; ai < 2; ++ai)
#pragma unroll
        for (int m = 0; m < 4; ++m) p[ai][m] = ld4(rsp + (size_t)(row0 + ai * 128 + m * 16) * 16 + 4 * fq);
#pragma unroll
    for (int ai = 0; ai < 2; ++ai)
#pragma unroll
        for (int m = 0; m < 4; ++m) { float s = (p[ai][m][0] + p[ai][m][1]) + (p[ai][m][2] + p[ai][m][3]); s += __shfl_xor(s, 16); s += __shfl_xor(s, 32);
            r[ai][m] = __builtin_amdgcn_rsqf(s * (1.f / 1024.f) + 1e-6f); }
}

struct EpiUp {
    static constexpr bool PERM = true, AFTER_DRAIN = false;
    bf16_t* O; const float* rowss; const float* sb; PG8_LAS float* rl; mutable int last_pm;
    __device__ __forceinline__ void operator()(const f32x4 (&acc)[2][2][4][2], const Unit& u, int wr, int wc, int fr, int fq) const {
        const int b = u.pm >> 3;
        const float* sbp = sb + (size_t)b * 5632 + u.pn * 256 + wc * 32 + 8 * fq;
        f32x4 sg[2], su[2];
#pragma unroll
        for (int n = 0; n < 2; ++n) { sg[n] = ld4(sbp + 4 * n); su[n] = ld4(sbp + 128 + 4 * n); }
        const int row0 = u.pm * 256 + wr * 64 + fr;
        bf16_t* ob = O + u.pn * 128 + wc * 32 + 8 * fq;
        float rr[2][4];
        PG8_LAS float* rw = rl + (wr * 4 + wc) * 128 + fr;
        if (u.pm != last_pm) {
            rstd8(rowss, row0, fq, rr);
            if (fq == 0) {
#pragma unroll
                for (int ai = 0; ai < 2; ++ai)
#pragma unroll
                    for (int m = 0; m < 4; ++m) rw[(ai * 4 + m) * 16] = rr[ai][m]; }
            last_pm = u.pm;
        } else {
#pragma unroll
            for (int ai = 0; ai < 2; ++ai)
#pragma unroll
                for (int m = 0; m < 4; ++m) rr[ai][m] = rw[(ai * 4 + m) * 16];
        }
#pragma unroll
        for (int ai = 0; ai < 2; ++ai)
#pragma unroll
            for (int m = 0; m < 4; ++m) {
                const int row = row0 + ai * 128 + m * 16; const float r = rr[ai][m]; const f32x2 r2 = {r, r};
                u32x4 w;
#pragma unroll
                for (int n = 0; n < 2; ++n) { const f32x4 ga = acc[ai][0][m][n], ua = acc[ai][1][m][n];
#pragma unroll
                    for (int h = 0; h < 2; ++h) {
                        const f32x2 g2 = (f32x2){ga[2 * h], ga[2 * h + 1]} * r2 + (f32x2){sg[n][2 * h], sg[n][2 * h + 1]};
                        const f32x2 u2 = (f32x2){ua[2 * h], ua[2 * h + 1]} * r2 + (f32x2){su[n][2 * h], su[n][2 * h + 1]};
                        const f32x2 t2 = g2 * (-1.44269504f);
                        f32x2 d2; d2.x = __builtin_amdgcn_exp2f(t2.x); d2.y = __builtin_amdgcn_exp2f(t2.y); d2 = d2 + 1.0f;
                        f32x2 q2; q2.x = __builtin_amdgcn_rcpf(d2.x); q2.y = __builtin_amdgcn_rcpf(d2.y);
                        const f32x2 a2 = (g2 * u2) * q2;
                        w[2 * n + h] = cvt_pk_bf16(a2.x, a2.y); } }
                st4u(ob + (size_t)row * 2816, w);
            }
    }
};

__device__ __forceinline__ f32x4 bf4_lo(u32x4 w) { f32x4 r; r[0] = __builtin_bit_cast(float, w[0] << 16); r[1] = __builtin_bit_cast(float, w[0] & 0xffff0000u); r[2] = __builtin_bit_cast(float, w[1] << 16); r[3] = __builtin_bit_cast(float, w[1] & 0xffff0000u); return r; }
__device__ __forceinline__ f32x4 bf4_hi(u32x4 w) { f32x4 r; r[0] = __builtin_bit_cast(float, w[2] << 16); r[1] = __builtin_bit_cast(float, w[2] & 0xffff0000u); r[2] = __builtin_bit_cast(float, w[3] << 16); r[3] = __builtin_bit_cast(float, w[3] & 0xffff0000u); return r; }
struct EpiResid {
    static constexpr bool PERM = true, AFTER_DRAIN = false;
    const void* base; void* out; int base_f32, out_f32; const float* gate; const float* bias;
    bf16_t* AP; const float* Gn; float* nrowss;
    __device__ __forceinline__ void operator()(const f32x4 (&acc)[2][2][4][2], const Unit& u, int wr, int wc, int fr, int fq) const {
        const int b = u.pm >> 3;
        const int col0 = u.pn * 256 + wc * 32 + 8 * fq;
        f32x4 gt[2][2], bs[2][2], G[2][2];
#pragma unroll
        for (int bj = 0; bj < 2; ++bj)
#pragma unroll
            for (int n = 0; n < 2; ++n) { const int c = col0 + 128 * bj + 4 * n;
                gt[bj][n] = ld4(gate + b * 1024 + c);
                bs[bj][n] = bias ? ld4(bias + c) : (f32x4){0.f, 0.f, 0.f, 0.f};
                G[bj][n] = AP ? ld4(Gn + b * 1024 + c) : (f32x4){0.f, 0.f, 0.f, 0.f}; }
        const int row0 = u.pm * 256 + wr * 64 + fr;
#pragma unroll
        for (int ai = 0; ai < 2; ++ai)
#pragma unroll
            for (int m = 0; m < 4; ++m) {
                const int row = row0 + ai * 128 + m * 16; const size_t off = (size_t)row * 1024 + col0; float ss = 0.f;
#pragma unroll
                for (int bj = 0; bj < 2; ++bj) { f32x4 xin[2], xn[2];
                    if (base_f32) { xin[0] = ld4((const float*)base + off + 128 * bj); xin[1] = ld4((const float*)base + off + 128 * bj + 4); }
                    else { const u32x4 w = ld4u((const bf16_t*)base + off + 128 * bj); xin[0] = bf4_lo(w); xin[1] = bf4_hi(w); }
#pragma unroll
                    for (int n = 0; n < 2; ++n) { xn[n] = xin[n] + gt[bj][n] * (acc[ai][bj][m][n] + bs[bj][n]);
                        ss += (xn[n][0] * xn[n][0] + xn[n][1] * xn[n][1]) + (xn[n][2] * xn[n][2] + xn[n][3] * xn[n][3]); }
                    if (out_f32) { st4f((float*)out + off + 128 * bj, xn[0]); st4f((float*)out + off + 128 * bj + 4, xn[1]); }
                    else st4u((bf16_t*)out + off + 128 * bj, pack8(xn[0], xn[1]));
                    if (AP) st4u(AP + off + 128 * bj, pack8(xn[0] * G[bj][0], xn[1] * G[bj][1])); }
                if (AP) { ss += __shfl_xor(ss, 16); ss += __shfl_xor(ss, 32); if (fq == 0) *(PG8_GAS float*)(nrowss + (size_t)row * 16 + u.pn * 4 + wc) = ss; }
                if (m & 1) asm volatile("" ::: "memory");
            }
    }
};

struct EpiQKV {
    static constexpr bool PERM = true, AFTER_DRAIN = false;
    bf16_t *Q, *K, *V; const float* rowss; const float* sb; const float* qg; const float* kg; const float* cosT; const float* sinT;
    __device__ __forceinline__ void operator()(const f32x4 (&acc)[2][2][4][2], const Unit& u, int wr, int wc, int fr, int fq) const {
        const int b = u.pm >> 3;
        const float* sbp = sb + (size_t)b * 1536 + u.pn * 256 + wc * 32 + 8 * fq;
        f32x4 sv[2][2], gv[2][2];
        const int typ = u.pn < 4 ? 0 : (u.pn == 4 ? 1 : 2);
        const float* gp = (typ == 0 ? qg : kg) + 8 * fq;
#pragma unroll
        for (int bj = 0; bj < 2; ++bj)
#pragma unroll
            for (int n = 0; n < 2; ++n) { sv[bj][n] = ld4(sbp + 128 * bj + 4 * n); gv[bj][n] = ld4(gp + 32 * bj + 4 * n); }
        const int row0 = u.pm * 256 + wr * 64 + fr;
        float rr[2][4]; rstd8(rowss, row0, fq, rr);
        bf16_t* dst; int pitch; float osc = 1.f;
        if (typ == 0) { dst = Q + (u.pn * 4 + wc) * 64 + 8 * fq; pitch = 1024; osc = 0.125f * 1.44269504f; }
        else if (typ == 1) { dst = K + wc * 64 + 8 * fq; pitch = 256; }
        else { dst = V + wc * 64 + 8 * fq; pitch = 256; }
#pragma unroll
        for (int ai = 0; ai < 2; ++ai)
#pragma unroll
            for (int m = 0; m < 4; ++m) {
                const int row = row0 + ai * 128 + m * 16; const float r = rr[ai][m];
                f32x4 v[2][2]; float ss = 0.f;
#pragma unroll
                for (int bj = 0; bj < 2; ++bj)
#pragma unroll
                    for (int n = 0; n < 2; ++n) { v[bj][n] = acc[ai][bj][m][n] * r + sv[bj][n];
                        ss += (v[bj][n][0] * v[bj][n][0] + v[bj][n][1] * v[bj][n][1]) + (v[bj][n][2] * v[bj][n][2] + v[bj][n][3] * v[bj][n][3]); }
                bf16_t* dp = dst + (size_t)row * pitch;
                if (typ == 2) {
                    st4u(dp, pack8(v[0][0], v[0][1])); st4u(dp + 32, pack8(v[1][0], v[1][1]));
                } else {
                    ss += __shfl_xor(ss, 16); ss += __shfl_xor(ss, 32);
                    const float rn = rstd_of(ss, 1.f / 64.f) * osc;
                    f32x4 o1[2], o2[2];
#pragma unroll
                    for (int n = 0; n < 2; ++n) { const f32x4 cs = ld4(cosT + (size_t)row * 32 + 8 * fq + 4 * n), sn = ld4(sinT + (size_t)row * 32 + 8 * fq + 4 * n);
                        const f32x4 y1 = v[0][n] * gv[0][n] * rn, y2 = v[1][n] * gv[1][n] * rn;
                        o1[n] = y1 * cs - y2 * sn; o2[n] = y2 * cs + y1 * sn; }
                    st4u(dp, pack8(o1[0], o1[1])); st4u(dp + 32, pack8(o2[0], o2[1]));
                }
            }
    }
};

struct EpiCin {
    static constexpr bool PERM = true, AFTER_DRAIN = false;
    bf16_t *U, *GB; const float* rowss; const float* sb;
    __device__ __forceinline__ void operator()(const f32x4 (&acc)[2][2][4][2], const Unit& u, int wr, int wc, int fr, int fq) const {
        const int b = u.pm >> 3;
        const float* sbp = sb + (size_t)b * 3072 + u.pn * 256 + wc * 32 + 8 * fq;
        f32x4 sv[2][2];
#pragma unroll
        for (int bj = 0; bj < 2; ++bj)
#pragma unroll
            for (int n = 0; n < 2; ++n) sv[bj][n] = ld4(sbp + 128 * bj + 4 * n);
        const int row0 = u.pm * 256 + wr * 64 + fr;
        float rr[2][4]; rstd8(rowss, row0, fq, rr);
        const bool isu = u.pn < 8;
        bf16_t* ob = isu ? U + u.pn * 128 + wc * 32 + 8 * fq : GB + (u.pn - 8) * 256 + wc * 32 + 8 * fq;
#pragma unroll
        for (int ai = 0; ai < 2; ++ai)
#pragma unroll
            for (int m = 0; m < 4; ++m) {
                const int row = row0 + ai * 128 + m * 16; const float r = rr[ai][m];
                f32x4 v[2][2];
#pragma unroll
                for (int bj = 0; bj < 2; ++bj)
#pragma unroll
                    for (int n = 0; n < 2; ++n) v[bj][n] = acc[ai][bj][m][n] * r + sv[bj][n];
                bf16_t* dp = ob + (size_t)row * 1024;
                if (isu) { st4u(dp, pack8(v[0][0] * v[1][0], v[0][1] * v[1][1])); }
                else { st4u(dp, pack8(v[0][0], v[0][1])); st4u(dp + 128, pack8(v[1][0], v[1][1])); }
            }
    }
};


struct StaticOrderPF : StaticOrder {
    const float* pbase; PG8_LAS unsigned char* dummy; int ptid;
    __device__ __forceinline__ void a_ready(const Unit& u) const {
#ifdef NO_PF
        return;
#endif
        const char* p = (const char*)pbase + ((size_t)(u.pm * 256) * 1024 + u.pn * 256) * 4;
#pragma unroll
        for (int i = 0; i < 4; ++i) { const int line = ptid + 512 * i;
            __builtin_amdgcn_global_load_lds((const unsigned*)(p + (size_t)(line >> 3) * 4096 + (line & 7) * 128), (PG8_LAS unsigned*)dummy, 4, 0, 0); }
    }
};
template <class Epi, class Sched, bool ALIGN_EPI = false, bool SP2 = false>
__device__ __forceinline__ void gemm_phase(PG8_LAS unsigned char* lds, const Gemm g, const Sched& S, const Epi& E, const int tid_in) {
    const int tid = tid_in, wid = __builtin_amdgcn_readfirstlane(tid >> 6), lane = tid & 63, wr = wid >> 2, wc = wid & 3, fr = lane & 15, fq = lane >> 4;
    const int K = g.K, nt = K / BK;
    unsigned voffA[2], voffB[2];
#pragma unroll
    for (int i = 0; i < 2; ++i) { int R, C; stage_rc(tid * 16 + i * 8192, R, C); const int Rb = Epi::PERM ? ((R & ~31) + perm32(R & 31)) : R;
        voffA[i] = (unsigned)(R * K + C) * 2u; voffB[i] = (unsigned)(Rb * K + C) * 2u; }
    const size_t kstep = (size_t)(BK * 2);
    const size_t hstep = (size_t)HALF * K * 2;
    const size_t tstep = 2 * hstep;
    const unsigned ldsw = (unsigned)wid * 1024u;
    const int aoff = lds_byte(wr * 64 + fr, fq * 8), boff = lds_byte(wc * 32 + fr, fq * 8);
#define PG8_SA(b, h) (((b) * 2 + (h)) * HTB)
#define PG8_SB(b, h) ((4 + (b) * 2 + (h)) * HTB)
#define PG8_STAGE(bufoff, gbase, voff) do { _Pragma("unroll") for (int _i = 0; _i < 2; ++_i) \
        __builtin_amdgcn_global_load_lds((const unsigned*)((const char*)(gbase) + (voff)[_i]), (PG8_LAS unsigned*)(lds + (bufoff) + ldsw + _i * 8192), 16, 0, 0); } while (0)
#define PG8_LDA(dst, b, h) do { _Pragma("unroll") for (int m = 0; m < 4; ++m) _Pragma("unroll") for (int k = 0; k < 2; ++k) dst[m][k] = *(const PG8_LAS bf16x8*)(lds + PG8_SA(b, h) + aoff + m * 2048 + k * 1024); } while (0)
#define PG8_LDB(dst, b, h) do { _Pragma("unroll") for (int n = 0; n < 2; ++n) _Pragma("unroll") for (int k = 0; k < 2; ++k) dst[n][k] = *(const PG8_LAS bf16x8*)(lds + PG8_SB(b, h) + boff + n * 2048 + k * 1024); } while (0)
#define PG8_MMA(ai, bj, At, Bt) do { __builtin_amdgcn_s_setprio(1); _Pragma("unroll") for (int m = 0; m < 4; ++m) _Pragma("unroll") for (int n = 0; n < 2; ++n) _Pragma("unroll") for (int k = 0; k < 2; ++k) \
        acc[ai][bj][m][n] = __builtin_amdgcn_mfma_f32_16x16x32_bf16(Bt[n][k], At[m][k], acc[ai][bj][m][n], 0, 0, 0); __builtin_amdgcn_s_setprio(0); } while (0)
#define PG8_WAIT_V(n) asm volatile("s_waitcnt vmcnt(" #n ")" ::: "memory")
#define PG8_WAIT_L(n) asm volatile("s_waitcnt lgkmcnt(" #n ")" ::: "memory")
#define PG8_BAR __builtin_amdgcn_s_barrier()
#define PG8_SCHED __builtin_amdgcn_sched_barrier(0)
    Unit cur, nxt; int ui = 0;
    if (!S.next(0, cur)) return;
    f32x4 acc[2][2][4][2];
#pragma unroll
    for (int a = 0; a < 2; ++a)
#pragma unroll
        for (int b = 0; b < 2; ++b)
#pragma unroll
            for (int m = 0; m < 4; ++m)
#pragma unroll
                for (int n = 0; n < 2; ++n) acc[a][b][m][n] = (f32x4){0.f, 0.f, 0.f, 0.f};
    bf16x8 At[4][2], B0[2][2], B1[2][2];
    const char* cA = (const char*)g.A + (size_t)cur.pm * tstep; const char* cB = (const char*)g.Bt + (size_t)cur.pn * tstep;
    S.a_ready(cur);
    if constexpr (SP2) {
        PG8_STAGE(PG8_SB(0, 0), cB, voffB); PG8_STAGE(PG8_SB(0, 1), cB + hstep, voffB); PG8_STAGE(PG8_SA(0, 0), cA, voffA); PG8_STAGE(PG8_SA(0, 1), cA + hstep, voffA);
        if (wr == 1) PG8_BAR;
        PG8_WAIT_V(2); PG8_BAR;
        PG8_STAGE(PG8_SB(1, 0), cB + kstep, voffB); PG8_STAGE(PG8_SA(1, 0), cA + kstep, voffA); PG8_STAGE(PG8_SB(1, 1), cB + hstep + kstep, voffB);
        PG8_WAIT_V(6); PG8_BAR;
    } else {
        PG8_STAGE(PG8_SB(0, 0), cB, voffB); PG8_STAGE(PG8_SA(0, 0), cA, voffA); PG8_STAGE(PG8_SB(0, 1), cB + hstep, voffB); PG8_STAGE(PG8_SA(0, 1), cA + hstep, voffA);
        if (wr == 1) PG8_BAR;
        PG8_WAIT_V(4); PG8_BAR;
        PG8_STAGE(PG8_SB(1, 0), cB + kstep, voffB); PG8_STAGE(PG8_SA(1, 0), cA + kstep, voffA); PG8_STAGE(PG8_SB(1, 1), cB + hstep + kstep, voffB);
        PG8_WAIT_V(6); PG8_BAR;
    }
    for (;;) {
        const bool has_next = S.next(ui + 1, nxt);
        const char* nA = has_next ? (const char*)g.A + (size_t)nxt.pm * tstep : cA; const char* nB = has_next ? (const char*)g.Bt + (size_t)nxt.pn * tstep : cB;
        for (int t = 0; t < nt; t += 2) {
            const bool last = (t == nt - 2);
            const char* a1 = cA + (size_t)(t + 1) * kstep;
            const char* a2 = last ? nA : cA + (size_t)(t + 2) * kstep; const char* b2 = last ? nB : cB + (size_t)(t + 2) * kstep;
            const char* a3 = a2 + kstep; const char* b3 = b2 + kstep;
            if (last && has_next) S.a_ready(nxt);
            if constexpr (SP2) {
            PG8_LDB(B0, 0, 0); PG8_LDB(B1, 0, 1); PG8_SCHED; PG8_LDA(At, 0, 0); PG8_STAGE(PG8_SA(1, 1), a1 + hstep, voffA);
            PG8_WAIT_V(8); PG8_WAIT_L(0); PG8_BAR; PG8_MMA(0, 0, At, B0); PG8_MMA(0, 1, At, B1); PG8_BAR; PG8_SCHED;
            PG8_LDA(At, 0, 1); PG8_STAGE(PG8_SB(0, 0), b2, voffB); PG8_STAGE(PG8_SB(0, 1), b2 + hstep, voffB); PG8_STAGE(PG8_SA(0, 0), a2, voffA);
            PG8_WAIT_V(8); PG8_WAIT_L(0); PG8_BAR; PG8_MMA(1, 0, At, B0); PG8_MMA(1, 1, At, B1); PG8_BAR; PG8_SCHED;
            PG8_LDB(B0, 1, 0); PG8_LDB(B1, 1, 1); PG8_SCHED; PG8_LDA(At, 1, 0); PG8_STAGE(PG8_SA(0, 1), a2 + hstep, voffA);
            PG8_WAIT_V(8); PG8_WAIT_L(0); PG8_BAR; PG8_MMA(0, 0, At, B0); PG8_MMA(0, 1, At, B1); PG8_BAR; PG8_SCHED;
            PG8_LDA(At, 1, 1); PG8_STAGE(PG8_SB(1, 0), b3, voffB); PG8_STAGE(PG8_SB(1, 1), b3 + hstep, voffB); PG8_STAGE(PG8_SA(1, 0), a3, voffA);
            PG8_WAIT_V(8); PG8_WAIT_L(0); PG8_BAR; PG8_MMA(1, 0, At, B0); PG8_MMA(1, 1, At, B1); PG8_BAR; PG8_SCHED;
            } else {
            PG8_LDB(B0, 0, 0); PG8_SCHED; PG8_LDA(At, 0, 0); PG8_STAGE(PG8_SA(1, 1), a1 + hstep, voffA);
            PG8_WAIT_L(8); PG8_BAR; PG8_WAIT_L(0); PG8_MMA(0, 0, At, B0); PG8_BAR; PG8_SCHED;
            PG8_LDB(B1, 0, 1); PG8_STAGE(PG8_SB(0, 0), b2, voffB);
            PG8_BAR; PG8_WAIT_L(0); PG8_MMA(0, 1, At, B1); PG8_BAR;
            PG8_LDA(At, 0, 1); PG8_STAGE(PG8_SA(0, 0), a2, voffA);
            PG8_BAR; PG8_WAIT_L(0); PG8_MMA(1, 0, At, B0); PG8_BAR; PG8_SCHED;
            PG8_STAGE(PG8_SB(0, 1), b2 + hstep, voffB);
            PG8_WAIT_V(6); PG8_BAR; PG8_MMA(1, 1, At, B1); PG8_BAR;
            PG8_LDB(B0, 1, 0); PG8_SCHED; PG8_LDA(At, 1, 0); PG8_STAGE(PG8_SA(0, 1), a2 + hstep, voffA);
            PG8_WAIT_L(8); PG8_BAR; PG8_WAIT_L(0); PG8_MMA(0, 0, At, B0); PG8_BAR; PG8_SCHED;
            PG8_LDB(B1, 1, 1); PG8_STAGE(PG8_SB(1, 0), b3, voffB);
            PG8_BAR; PG8_WAIT_L(0); PG8_MMA(0, 1, At, B1); PG8_BAR;
            PG8_LDA(At, 1, 1); PG8_STAGE(PG8_SA(1, 0), a3, voffA);
            PG8_BAR; PG8_WAIT_L(0); PG8_MMA(1, 0, At, B0); PG8_BAR; PG8_SCHED;
            PG8_STAGE(PG8_SB(1, 1), b3 + hstep, voffB);
            PG8_WAIT_V(6); PG8_BAR; PG8_MMA(1, 1, At, B1); PG8_BAR;
            }
        }
        if constexpr (ALIGN_EPI) { if (wr == 0) PG8_BAR; }
        if constexpr (!Epi::AFTER_DRAIN) { E(acc, cur, wr, wc, fr, fq); S.done(cur); }
        if (!has_next) break;
#pragma unroll
        for (int a = 0; a < 2; ++a)
#pragma unroll
            for (int b = 0; b < 2; ++b)
#pragma unroll
                for (int m = 0; m < 4; ++m)
#pragma unroll
                    for (int n = 0; n < 2; ++n) acc[a][b][m][n] = (f32x4){0.f, 0.f, 0.f, 0.f};
        cur = nxt; cA = nA; cB = nB; ++ui;
        if constexpr (ALIGN_EPI) { if (wr == 1) PG8_BAR; }
    }
    PG8_WAIT_V(0);
    if constexpr (!ALIGN_EPI) { if (wr == 0) PG8_BAR; }
    PG8_BAR;
    if constexpr (Epi::AFTER_DRAIN) { E.fused(acc, cur, wr, wc, fr, fq, lds, wid, lane); S.done(cur); }
#undef PG8_SA
#undef PG8_SB
#undef PG8_STAGE
#undef PG8_LDA
#undef PG8_LDB
#undef PG8_MMA
#undef PG8_WAIT_V
#undef PG8_WAIT_L
#undef PG8_BAR
#undef PG8_SCHED
}
}

#define LAS __attribute__((address_space(3)))
typedef pg8::bf16_t bf16_t;
typedef short bf16x8 __attribute__((ext_vector_type(8)));
typedef short s16x4 __attribute__((ext_vector_type(4)));
typedef float f32x4 __attribute__((ext_vector_type(4)));
typedef float f32x16 __attribute__((ext_vector_type(16)));
typedef unsigned u32x4 __attribute__((ext_vector_type(4)));
typedef unsigned u32x2 __attribute__((ext_vector_type(2)));

constexpr int DM = 1024, NBATCH = 16, SEQ = 2048, MROWS = NBATCH * SEQ, DFF = 2816, NUP = 2 * DFF, NQKV = 1536, NCIN = 3072, NADA = 9 * DM, DEPTH = 4;
constexpr int NWAVES = 8, NTHREADS = NWAVES * 64;
constexpr int LDS_BYTES = 131072 + 1024 + 4096;
constexpr size_t MiB = 1u << 20;
constexpr size_t WS_UP = 0, WS_DN = 88 * MiB, WS_QKV = 132 * MiB, WS_O = 138 * MiB, WS_CIN = 142 * MiB, WS_COUT = 154 * MiB;
constexpr size_t WS_MOD = 158 * MiB, WS_SB = 161 * MiB, WS_RS = 166 * MiB, WS_COS = 168 * MiB, WS_SIN = 172 * MiB, WS_GT = 176 * MiB, WS_GATE = 177 * MiB, WS_AP = 178 * MiB, WS_BIG = 242 * MiB, WS_XALT = 434 * MiB, WS_END = 562 * MiB;
constexpr size_t WS_PAR = 177 * MiB + 768 * 1024;
constexpr int PAR_BO = 0, PAR_QG = 2048, PAR_KG = 2176, PAR_SINK = 2304, PAR_CW = 2336, PAR_N = 2336 + 6144;
constexpr size_t WS_BARW = WS_PAR + 64 * 1024;
constexpr size_t SB_STRIDE = (size_t)16 * NUP;
constexpr int NPH = 2 + 7 * DEPTH;

struct Args { const void* in[18]; float* out; unsigned char* ws; int ph_lo, ph_hi; };

__device__ const float INVF[32] = {1.0f, 0.7498942613601685f, 0.5623413324356079f, 0.4216965138912201f, 0.3162277638912201f, 0.23713737726211548f, 0.17782793939113617f, 0.133352130651474f,
    0.10000000149011612f, 0.07498941570520401f, 0.05623413249850273f, 0.04216965287923813f, 0.03162277489900589f, 0.023713737726211548f, 0.017782794311642647f, 0.01333521492779255f,
    0.009999999776482582f, 0.007498941849917173f, 0.005623413249850273f, 0.0042169648222625256f, 0.003162277629598975f, 0.00237137358635664f, 0.0017782794311642647f, 0.0013335214462131262f,
    0.0010000000474974513f, 0.0007498942431993783f, 0.000562341301701963f, 0.0004216965171508491f, 0.0003162277571391314f, 0.00023713737027719617f, 0.00017782794020604342f, 0.0001333521504420787f};

#define LDS_WAIT() asm volatile("s_waitcnt lgkmcnt(0)" ::: "memory")
__device__ __forceinline__ unsigned f2bf(float f) { unsigned u = __builtin_bit_cast(unsigned, f); return (u + 0x7fffu + ((u >> 16) & 1u)) >> 16; }
__device__ __forceinline__ unsigned pk2(float lo, float hi) { return f2bf(lo) | (f2bf(hi) << 16); }
__device__ __forceinline__ float bf_lo(unsigned w) { return __builtin_bit_cast(float, w << 16); }
__device__ __forceinline__ float bf_hi(unsigned w) { return __builtin_bit_cast(float, w & 0xffff0000u); }
__device__ __forceinline__ float wave_sum(float v) {
#pragma unroll
    for (int o = 1; o < 64; o <<= 1) v += __shfl_xor(v, o);
    return v;
}

#define RLX_AGENT __ATOMIC_RELAXED, __HIP_MEMORY_SCOPE_AGENT
#define XB_TMO      128
#define XB_XCNT(j)  (256  + 64 * (j))
#define XB_XSUB(j)  (1280 + 64 * (j))
#define XB_XGEN(j)  (2304 + 64 * (j))
#define XB_TOP      3328
#define XB_TOPGEN   3392
#define XCD_BAR_WORDS 3456
#define XB_SPIN_CAP (1u << 18)

__device__ __forceinline__ unsigned xb_ld(unsigned* p)              { return __hip_atomic_load(p, __ATOMIC_RELAXED, __HIP_MEMORY_SCOPE_AGENT); }
__device__ __forceinline__ unsigned xb_add(unsigned* p, unsigned v) { return __hip_atomic_fetch_add(p, v, __ATOMIC_RELAXED, __HIP_MEMORY_SCOPE_AGENT); }
__device__ __forceinline__ unsigned xb_xcc_id() { return (unsigned)__builtin_amdgcn_s_getreg((3 << 11) | 20) & 0xFu; }
#define XB_SPIN(cond, bar) do { unsigned _sp = 0; while (cond) { __builtin_amdgcn_s_sleep(1); \
    if ((++_sp & 255u) == 0u) { if (xb_ld(&(bar)[XB_TMO])) break; if (_sp > XB_SPIN_CAP) { atomicAdd(&(bar)[XB_TMO], 1u); break; } } } } while (0)

struct XcdBarrier {
    unsigned* bar; unsigned x;
    volatile LAS unsigned* st;
};

__device__ __forceinline__ XcdBarrier xcd_barrier_post(unsigned* bar, volatile LAS unsigned* st) {
    XcdBarrier b; b.bar = bar; b.x = xb_xcc_id(); b.st = st;
    if (threadIdx.x == 0) (void)xb_add(&bar[XB_XCNT(b.x)], 1u);
    return b;
}
__device__ __forceinline__ void xcd_barrier_complete(unsigned* bar, unsigned x, unsigned& nloc, unsigned& nx) {
    const unsigned G = gridDim.x * gridDim.y * gridDim.z;
    unsigned sum, cnt, mine, sp = 0u;
    for (;;) {
        sum = 0u; cnt = 0u; mine = 0u;
#pragma unroll
        for (unsigned j = 0; j < 16; ++j) { const unsigned c = xb_ld(&bar[XB_XCNT(j)]); sum += c; cnt += (c > 0u) ? 1u : 0u; mine = (j == x) ? c : mine; }
        if (sum == G) break;
        __builtin_amdgcn_s_sleep(1);
        if ((++sp & 255u) == 0u) { if (xb_ld(&bar[XB_TMO])) break; if (sp > XB_SPIN_CAP) { atomicAdd(&bar[XB_TMO], 1u); break; } }
    }
    nloc = mine > 0u ? mine : 1u; nx = cnt > 0u ? cnt : 1u;
}

__device__ __forceinline__ void xcd_barrier(const XcdBarrier& b) {
    asm volatile("s_waitcnt vmcnt(0)" ::: "memory");
    __syncthreads();
    if (threadIdx.x == 0) {
        unsigned* bar = b.bar;
        __builtin_amdgcn_s_waitcnt(0);
        unsigned nloc = b.st[0], nx = b.st[1];
        if (nloc == 0u) { xcd_barrier_complete(bar, b.x, nloc, nx); b.st[0] = nloc; b.st[1] = nx; }
        const unsigned old = xb_add(&bar[XB_XSUB(b.x)], 1u);
        const unsigned gen = old / nloc;
        if (old + 1u == (gen + 1u) * nloc) {
            __builtin_amdgcn_fence(__ATOMIC_RELEASE, "agent");
            asm volatile("s_waitcnt vmcnt(0)" ::: "memory");
            const unsigned og = xb_add(&bar[XB_TOP], 1u);
            const unsigned tg = og / nx;
            if (og + 1u == (tg + 1u) * nx) xb_add(&bar[XB_TOPGEN], 1u);
            else XB_SPIN(xb_ld(&bar[XB_TOPGEN]) == tg, bar);
            __builtin_amdgcn_fence(__ATOMIC_ACQUIRE, "agent");
            xb_add(&bar[XB_XGEN(b.x)], 1u);
            asm volatile("s_waitcnt vmcnt(0)" ::: "memory");
        } else {
            XB_SPIN(xb_ld(&bar[XB_XGEN(b.x)]) == gen, bar);
            __builtin_amdgcn_fence(__ATOMIC_ACQUIRE, "agent");
            asm volatile("s_waitcnt vmcnt(0)" ::: "memory");
        }
    }
    __syncthreads();
}

__device__ __forceinline__ int srcblk(int mode, int nb) {
    const int pn = nb >> 3, q = nb & 7;
    if (mode == 0) return nb;
    if (mode == 1) return (q >> 2) * 88 + 4 * pn + (q & 3);
    if (mode == 2) return 8 * pn + 2 * (q & 3) + (q >> 2);
    return pn < 8 ? 32 * (1 + (q >> 2)) + 4 * pn + (q & 3) : 8 * (pn - 8) + q;
}
__device__ __forceinline__ void transpose_item(const float* W, int K, int N, bf16_t* WT, int mode, LAS float* scr, int item, int lane) {
    const int nblk = N / 32, kb = item / nblk, nb = item % nblk, k0 = 64 * kb, n0 = 32 * nb, s0 = 32 * srcblk(mode, nb);
    float wv[32];
    const float* wsrc = W + (size_t)(k0 + (lane >> 5)) * N + s0 + (lane & 31);
#pragma unroll
    for (int i = 0; i < 32; ++i) wv[i] = wsrc[(size_t)(2 * i) * N];
#pragma unroll
    for (int i = 0; i < 32; ++i) scr[(2 * i + (lane >> 5)) * 33 + (lane & 31)] = wv[i];
    LDS_WAIT(); asm volatile("" ::: "memory");
    const int c = lane & 7;
#pragma unroll
    for (int j = 0; j < 4; ++j) { const int n = (lane >> 3) + 8 * j; const LAS float* s = scr + (8 * c) * 33 + n;
        u32x4 o; o.x = pk2(s[0 * 33], s[1 * 33]); o.y = pk2(s[2 * 33], s[3 * 33]); o.z = pk2(s[4 * 33], s[5 * 33]); o.w = pk2(s[6 * 33], s[7 * 33]);
        *(u32x4*)(WT + (size_t)(n0 + n) * K + k0 + 8 * c) = o; }
    LDS_WAIT(); asm volatile("" ::: "memory");
}
constexpr int IT_UP = 8 * 2816, IT_DN = 8 * 1408, IT_QKV = 2 * 768, IT_O = 2 * 512, IT_CIN = 2 * 1536, IT_COUT = 2 * 512;
constexpr int NITEMS = IT_UP + IT_DN + IT_QKV + IT_O + IT_CIN + IT_COUT;
__device__ __forceinline__ void conv_item(const Args& a, int it, LAS float* scr, int lane) {
    unsigned char* ws = a.ws; int r = it;
    if (r < IT_UP) { const int i = r / 2816; r -= i * 2816; transpose_item((const float*)a.in[6] + (size_t)i * 1024 * NUP, 1024, NUP, (bf16_t*)(ws + WS_UP) + (size_t)i * NUP * 1024, 1, scr, r, lane); return; }
    r -= IT_UP;
    if (r < IT_DN) { const int i = r / 1408; r -= i * 1408; transpose_item((const float*)a.in[7] + (size_t)i * DFF * 1024, DFF, 1024, (bf16_t*)(ws + WS_DN) + (size_t)i * 1024 * DFF, 0, scr, r, lane); return; }
    r -= IT_DN;
    if (r < IT_QKV) { const int i = r / 768; r -= i * 768; transpose_item((const float*)a.in[8] + (size_t)i * 1024 * NQKV, 1024, NQKV, (bf16_t*)(ws + WS_QKV) + (size_t)i * NQKV * 1024, 2, scr, r, lane); return; }
    r -= IT_QKV;
    if (r < IT_O) { const int i = r / 512; r -= i * 512; transpose_item((const float*)a.in[13] + (size_t)i * 1024 * 1024, 1024, 1024, (bf16_t*)(ws + WS_O) + (size_t)i * 1024 * 1024, 0, scr, r, lane); return; }
    r -= IT_O;
    if (r < IT_CIN) { const int i = r / 1536; r -= i * 1536; transpose_item((const float*)a.in[15] + (size_t)i * 1024 * NCIN, 1024, NCIN, (bf16_t*)(ws + WS_CIN) + (size_t)i * NCIN * 1024, 3, scr, r, lane); return; }
    r -= IT_CIN;
    { const int i = r / 512; r -= i * 512; transpose_item((const float*)a.in[17] + (size_t)i * 1024 * 1024, 1024, 1024, (bf16_t*)(ws + WS_COUT) + (size_t)i * 1024 * 1024, 0, scr, r, lane); }
}

constexpr int GEMV_TASKS = DEPTH * (NADA / 256);
__device__ __forceinline__ void gemv_task(const Args& a, int task, LAS unsigned char* lds, int tid, int lane, int wid) {
    const float* c = (const float*)a.in[1]; const float* w_ada = (const float*)a.in[4]; const float* b_ada = (const float*)a.in[5];
    float* mod = (float*)(a.ws + WS_MOD);
    LAS float* cact = (LAS float*)lds;
    LAS float* red = (LAS float*)(lds + 65536);
    const int l = task / 36, n0 = (task % 36) * 256;
    __syncthreads();
    { int t0 = tid; asm volatile("" : "+v"(t0));
#pragma unroll 4
      for (int i = 0; i < 32; ++i) { const int idx = t0 + 512 * i, k = idx >> 4, b = idx & 15; const float v = c[b * 1024 + k]; cact[idx] = v / (1.f + __expf(-v)); } }
    __syncthreads();
    float acc[64];
#pragma unroll
    for (int i = 0; i < 64; ++i) acc[i] = 0.f;
    const float* wp = w_ada + ((size_t)l * 1024 + wid * 128) * NADA + n0 + 4 * lane;
#pragma unroll 1
    for (int kb = 0; kb < 128; kb += 8) {
        f32x4 wv[8];
#pragma unroll
        for (int u = 0; u < 8; ++u) wv[u] = *(const f32x4*)(wp + (size_t)(kb + u) * NADA);
#pragma unroll
        for (int u = 0; u < 8; ++u) {
            const LAS f32x4* cp = (const LAS f32x4*)(cact + (wid * 128 + kb + u) * 16);
#pragma unroll
            for (int bq = 0; bq < 4; ++bq) { const f32x4 cb = cp[bq];
#pragma unroll
                for (int e = 0; e < 4; ++e)
#pragma unroll
                    for (int j = 0; j < 4; ++j) acc[(bq * 4 + e) * 4 + j] += cb[e] * wv[u][j]; }
            asm volatile("" ::: "memory");
        }
    }
#pragma unroll
    for (int r = 0; r < 2; ++r) {
#pragma unroll
        for (int q = 0; q < 32; ++q) red[(wid * 32 + q) * 64 + lane] = acc[32 * r + q];
        __syncthreads();
#pragma unroll
        for (int i = 0; i < 4; ++i) { const int idx = tid + 512 * i, q = idx >> 6, ln = idx & 63; float s = 0.f;
#pragma unroll
            for (int w = 0; w < 8; ++w) s += red[(w * 32 + q) * 64 + ln];
            const int A = 32 * r + q, bb = A >> 2, j = A & 3;
            mod[((size_t)l * 16 + bb) * NADA + n0 + 4 * ln + j] = s + b_ada[l * NADA + n0 + 4 * ln + j]; }
        __syncthreads();
    }
}

__device__ __forceinline__ void sincos_acc(float angf, float& co, float& si) {
    const double a = (double)angf;
    const double qd = __builtin_rint(a * 0.63661977236758134308);
    const double r = __builtin_fma(-qd, 1.57079632679489661923, a), r2 = r * r;
    double sp = 1.0 / 6227020800.0; sp = sp * r2 - 1.0 / 39916800.0; sp = sp * r2 + 1.0 / 362880.0; sp = sp * r2 - 1.0 / 5040.0; sp = sp * r2 + 1.0 / 120.0; sp = sp * r2 - 1.0 / 6.0; sp = sp * r2 + 1.0; sp = sp * r;
    double cp = 1.0 / 479001600.0; cp = cp * r2 - 1.0 / 3628800.0; cp = cp * r2 + 1.0 / 40320.0; cp = cp * r2 - 1.0 / 720.0; cp = cp * r2 + 1.0 / 24.0; cp = cp * r2 - 0.5; cp = cp * r2 + 1.0;
    const int q = ((int)qd) & 3;
    const double s = (q == 0) ? sp : (q == 1) ? cp : (q == 2) ? -sp : -cp;
    const double cc = (q == 0) ? cp : (q == 1) ? -sp : (q == 2) ? -cp : sp;
    co = (float)cc; si = (float)s;
}

__device__ __forceinline__ void p0a(const Args& a, LAS unsigned char* lds, int tid, int lane, int wid) {
    const int G = gridDim.x, bx = blockIdx.x;
    int ngemv = G < GEMV_TASKS ? G : GEMV_TASKS;
    constexpr int XSPLIT = 3840;
    if (bx < ngemv) { for (int t = bx; t < GEMV_TASKS; t += ngemv) gemv_task(a, t, lds, tid, lane, wid); __syncthreads(); }
    LAS float* scr = (LAS float*)(lds + wid * 16384);
    int xs = 0;
    if (G > ngemv) { xs = XSPLIT; if (bx >= ngemv) { const int nw = (G - ngemv) * NWAVES; for (int it = (bx - ngemv) * NWAVES + wid; it < xs; it += nw) conv_item(a, it, scr, lane); } }
    { const int nw = G * NWAVES; for (int it = xs + bx * NWAVES + wid; it < NITEMS; it += nw) conv_item(a, it, scr, lane); }
    if (bx == 0) { unsigned* bw = (unsigned*)(a.ws + WS_BARW); for (int i = tid; i < XCD_BAR_WORDS; i += NTHREADS) bw[i] = 0u; }
    const int gt = bx * NTHREADS + tid, nt = G * NTHREADS;
    const int* pos = (const int*)a.in[2]; float* cosT = (float*)(a.ws + WS_COS); float* sinT = (float*)(a.ws + WS_SIN);
    for (int idx = gt; idx < MROWS * 32; idx += nt) { const int row = idx >> 5, p = idx & 31; const float ang = (float)pos[row] * INVF[p]; float co, si; sincos_acc(ang, co, si); cosT[idx] = co; sinT[idx] = si; }
}

constexpr int SB_TASKS = (8 * NUP + 2 * NQKV + 2 * NCIN) / 16;
__device__ __forceinline__ void sb_task(const Args& a, int task, int lane) {
    int s = 0, r = task, N = NUP;
    for (s = 0; s < 12; ++s) { const int l = s / 3, j = s % 3; N = (j != 1) ? NUP : ((l & 1) ? NCIN : NQKV); if (r < N / 16) break; r -= N / 16; }
    const int l = s / 3, j = s % 3;
    const bf16_t* Bt;
    if (j == 0) Bt = (const bf16_t*)(a.ws + WS_UP) + (size_t)(2 * l) * NUP * 1024;
    else if (j == 2) Bt = (const bf16_t*)(a.ws + WS_UP) + (size_t)(2 * l + 1) * NUP * 1024;
    else if (l & 1) Bt = (const bf16_t*)(a.ws + WS_CIN) + (size_t)(l >> 1) * NCIN * 1024;
    else Bt = (const bf16_t*)(a.ws + WS_QKV) + (size_t)(l >> 1) * NQKV * 1024;
    const float* shift = (const float*)(a.ws + WS_MOD) + (size_t)l * 16 * NADA + 3 * j * 1024;
    float* sb = (float*)(a.ws + WS_SB) + (size_t)s * SB_STRIDE;
    const int n0 = 16 * r, i16 = lane & 15, kq = lane >> 4;
    const bf16_t* bp = Bt + (size_t)(n0 + i16) * 1024 + 8 * kq;
    const float* sp = shift + (size_t)i16 * NADA + 8 * kq;
    f32x4 c = {0.f, 0.f, 0.f, 0.f};
#pragma unroll 8
    for (int kk = 0; kk < 32; ++kk) {
        const bf16x8 wb = *(const bf16x8*)(bp + 32 * kk);
        const f32x4 s0 = *(const f32x4*)(sp + 32 * kk), s1 = *(const f32x4*)(sp + 32 * kk + 4);
        u32x4 w; w.x = pk2(s0[0], s0[1]); w.y = pk2(s0[2], s0[3]); w.z = pk2(s1[0], s1[1]); w.w = pk2(s1[2], s1[3]);
        c = __builtin_amdgcn_mfma_f32_16x16x32_bf16(wb, __builtin_bit_cast(bf16x8, w), c, 0, 0, 0);
    }
    const int n = n0 + 4 * kq;
    if (j == 1 && !(l & 1)) { const int pn = n >> 8, q = (n >> 5) & 7, src = 256 * pn + 64 * (q & 3) + 32 * (q >> 2) + (n & 31);
        const f32x4 bv = *(const f32x4*)((const float*)a.in[9] + (size_t)(l >> 1) * NQKV + src); c = c + bv; }
    *(f32x4*)(sb + (size_t)i16 * N + n) = c;
}
__device__ __forceinline__ void p0b(const Args& a, int tid, int lane, int wid) {
    const int gw = blockIdx.x * NWAVES + wid, NGW = gridDim.x * NWAVES;
    for (int t = gw; t < SB_TASKS; t += NGW) sb_task(a, t, lane);
    const float* x = (const float*)a.in[0]; const float* gain = (const float*)a.in[3]; const float* mod = (const float*)(a.ws + WS_MOD);
    { float* par = (float*)(a.ws + WS_PAR);
      for (int idx = blockIdx.x * NTHREADS + tid; idx < PAR_N; idx += gridDim.x * NTHREADS) { float v;
          if (idx < PAR_QG) v = ((const float*)a.in[14])[idx]; else if (idx < PAR_KG) v = ((const float*)a.in[10])[idx - PAR_QG]; else if (idx < PAR_SINK) v = ((const float*)a.in[11])[idx - PAR_KG];
          else if (idx < PAR_CW) v = ((const float*)a.in[12])[idx - PAR_SINK]; else v = ((const float*)a.in[16])[idx - PAR_CW];
          par[idx] = v; } }
    { float* GT = (float*)(a.ws + WS_GT); float* GATE = (float*)(a.ws + WS_GATE);
      for (int idx = blockIdx.x * NTHREADS + tid; idx < 12 * 16 * 1024; idx += gridDim.x * NTHREADS) { const int s = idx >> 14, b = (idx >> 10) & 15, k = idx & 1023, l = s / 3, j = s % 3;
          const float* m = mod + ((size_t)l * 16 + b) * NADA + 3 * j * 1024; GT[idx] = gain[s * 1024 + k] * (1.0f + m[1024 + k]); GATE[idx] = (j == 1 ? 1.0f : 0.5f) * m[2048 + k]; } }
    bf16_t* AP = (bf16_t*)(a.ws + WS_AP); float* rs = (float*)(a.ws + WS_RS);
    for (int row = gw; row < MROWS; row += NGW) {
        const int b = row >> 11; const float* xr = x + (size_t)row * 1024 + 4 * lane; const float* sc = mod + (size_t)b * NADA + 1024 + 4 * lane;
        f32x4 v[4]; float ss = 0.f;
#pragma unroll
        for (int j = 0; j < 4; ++j) { v[j] = *(const f32x4*)(xr + 256 * j); ss += (v[j][0] * v[j][0] + v[j][1] * v[j][1]) + (v[j][2] * v[j][2] + v[j][3] * v[j][3]); }
        ss = wave_sum(ss);
        if (lane < 4) *(f32x4*)(rs + (size_t)row * 16 + 4 * lane) = (f32x4){lane == 0 ? ss : 0.f, 0.f, 0.f, 0.f};
#pragma unroll
        for (int j = 0; j < 4; ++j) { const f32x4 g = *(const f32x4*)(gain + 4 * lane + 256 * j) * (*(const f32x4*)(sc + 256 * j) + 1.0f); const f32x4 o = v[j] * g;
            u32x2 w; w.x = pk2(o[0], o[1]); w.y = pk2(o[2], o[3]); *(u32x2*)(AP + (size_t)row * 1024 + 4 * lane + 256 * j) = w; }
    }
}

constexpr int ATT_KS = 144, ATT_VS = 260, ATT_VOFF = 256 * ATT_KS;
__device__ __forceinline__ void attn_phase(LAS unsigned char* lds, const bf16_t* Q, const bf16_t* K, const bf16_t* V, bf16_t* O, const float* sinks, int tid, int lane, int wid, int u_first, int u_end, int u_step) {
    const int q32 = lane & 31, hi = lane >> 5;
    const float NEG = -__builtin_inff();
    for (int unit = u_first; unit < u_end; unit += u_step) {
        const int qb = unit & 15, kvh = (unit >> 4) & 3, b = unit >> 6;
        const size_t rowbase = (size_t)b * SEQ; const int kstart = (qb - 1) * 128;
        __syncthreads();
#pragma unroll
        for (int i = 0; i < 4; ++i) { const int idx = tid + 512 * i, row = idx >> 3, ch = idx & 7, kr = kstart + row;
            u32x4 kv = {0u, 0u, 0u, 0u}, vv = {0u, 0u, 0u, 0u};
            if (kr >= 0) { kv = *(const u32x4*)(K + (rowbase + kr) * 256 + kvh * 64 + ch * 8); vv = *(const u32x4*)(V + (rowbase + kr) * 256 + kvh * 64 + ch * 8); }
            *(LAS u32x4*)(lds + row * ATT_KS + ch * 16) = kv;
            LAS bf16_t* vt = (LAS bf16_t*)(lds + ATT_VOFF) + (ch * 8) * ATT_VS + row;
#pragma unroll
            for (int e = 0; e < 8; ++e) vt[e * ATT_VS] = (bf16_t)((vv[e >> 1] >> (16 * (e & 1))) & 0xffffu);
        }
        __syncthreads();
        const int head = kvh * 4 + (wid >> 1), h2 = wid & 1;
        const float sink2 = sinks[head] * 1.44269504f;
#pragma unroll 1
        for (int qi = 0; qi < 2; ++qi) {
            const int qo = 64 * h2 + 32 * qi, kt0 = qo >> 5;
            const size_t qrow = rowbase + qb * 128 + qo + q32;
            bf16x8 qr[4];
#pragma unroll
            for (int ks = 0; ks < 4; ++ks) qr[ks] = *(const bf16x8*)(Q + qrow * 1024 + head * 64 + ks * 16 + hi * 8);
            f32x16 s[5];
#pragma unroll
            for (int j = 0; j < 5; ++j) {
                const int kt = kt0 + j;
                f32x16 acc = {0.f, 0.f, 0.f, 0.f, 0.f, 0.f, 0.f, 0.f, 0.f, 0.f, 0.f, 0.f, 0.f, 0.f, 0.f, 0.f};
#pragma unroll
                for (int ks = 0; ks < 4; ++ks) { const bf16x8 ka = *(const LAS bf16x8*)(lds + (32 * kt + q32) * ATT_KS + ks * 32 + hi * 16);
                    acc = __builtin_amdgcn_mfma_f32_32x32x16_bf16(ka, qr[ks], acc, 0, 0, 0); }
                const bool dead = (qb == 0) && (kt < 4);
#pragma unroll
                for (int r = 0; r < 16; ++r) { const int key = (r & 3) + 8 * (r >> 2) + 4 * hi;
                    bool ok = !dead;
                    if (j == 0) ok = ok && (q32 < key);
                    if (j == 4) ok = ok && (key <= q32);
                    acc[r] = ok ? acc[r] : NEG; }
                s[j] = acc;
            }
            float mx = sink2;
#pragma unroll
            for (int j = 0; j < 5; ++j)
#pragma unroll
                for (int r = 0; r < 16; ++r) mx = fmaxf(mx, s[j][r]);
            mx = fmaxf(mx, __shfl_xor(mx, 32));
            float l = 0.f;
#pragma unroll
            for (int j = 0; j < 5; ++j)
#pragma unroll
                for (int r = 0; r < 16; ++r) { const float p = __builtin_amdgcn_exp2f(s[j][r] - mx); s[j][r] = p; l += p; }
            l += __shfl_xor(l, 32);
            l += __builtin_amdgcn_exp2f(sink2 - mx);
            f32x16 o[2];
#pragma unroll
            for (int db = 0; db < 2; ++db) o[db] = (f32x16){0.f, 0.f, 0.f, 0.f, 0.f, 0.f, 0.f, 0.f, 0.f, 0.f, 0.f, 0.f, 0.f, 0.f, 0.f, 0.f};
#pragma unroll
            for (int j = 0; j < 5; ++j) {
                const int kt = kt0 + j;
#pragma unroll
                for (int st = 0; st < 2; ++st) {
                    u32x4 pw; pw.x = pg8::cvt_pk_bf16(s[j][8 * st + 0], s[j][8 * st + 1]); pw.y = pg8::cvt_pk_bf16(s[j][8 * st + 2], s[j][8 * st + 3]);
                    pw.z = pg8::cvt_pk_bf16(s[j][8 * st + 4], s[j][8 * st + 5]); pw.w = pg8::cvt_pk_bf16(s[j][8 * st + 6], s[j][8 * st + 7]);
                    const bf16x8 pb = __builtin_bit_cast(bf16x8, pw);
#pragma unroll
                    for (int db = 0; db < 2; ++db) {
                        const LAS unsigned char* vp = lds + ATT_VOFF + ((q32 + 32 * db) * ATT_VS + 32 * kt + 16 * st + 4 * hi) * 2;
                        const s16x4 lo = *(const LAS s16x4*)(vp), hh = *(const LAS s16x4*)(vp + 16);
                        const bf16x8 va = {lo[0], lo[1], lo[2], lo[3], hh[0], hh[1], hh[2], hh[3]};
                        o[db] = __builtin_amdgcn_mfma_f32_32x32x16_bf16(va, pb, o[db], 0, 0, 0);
                    }
                }
            }
            const float inv = 1.0f / l;
            bf16_t* op = O + qrow * 1024 + head * 64 + 4 * hi;
#pragma unroll
            for (int db = 0; db < 2; ++db)
#pragma unroll
                for (int rq = 0; rq < 4; ++rq) { u32x2 w; w.x = pg8::cvt_pk_bf16(o[db][4 * rq] * inv, o[db][4 * rq + 1] * inv); w.y = pg8::cvt_pk_bf16(o[db][4 * rq + 2] * inv, o[db][4 * rq + 3] * inv);
                    *(u32x2*)(op + 32 * db + 8 * rq) = w; }
        }
    }
}

__device__ __forceinline__ void unpack8(u32x4 w, float (&f)[8]) {
#pragma unroll
    for (int i = 0; i < 4; ++i) { f[2 * i] = bf_lo(w[i]); f[2 * i + 1] = bf_hi(w[i]); }
}
__device__ __forceinline__ void conv_phase(const bf16_t* U, const bf16_t* GB, bf16_t* A2, const float* cw, int tid, int t_first, int t_end, int t_step) {
    const int c8 = (tid & 127) * 8, chunk = tid >> 7;
    float w0[8], w1[8], w2[8];
#pragma unroll
    for (int e = 0; e < 8; ++e) { w0[e] = cw[c8 + e]; w1[e] = cw[1024 + c8 + e]; w2[e] = cw[2048 + c8 + e]; }
    for (int task = t_first; task < t_end; task += t_step) {
        const int rstart = task * 64 + chunk * 16, t0 = rstart & (SEQ - 1);
        float um2[8], um1[8];
        if (t0 > 0) { unpack8(*(const u32x4*)(U + (size_t)(rstart - 2) * 1024 + c8), um2); unpack8(*(const u32x4*)(U + (size_t)(rstart - 1) * 1024 + c8), um1); }
        else {
#pragma unroll
            for (int e = 0; e < 8; ++e) { um2[e] = 0.f; um1[e] = 0.f; } }
#pragma unroll 4
        for (int i = 0; i < 16; ++i) {
            const size_t off = (size_t)(rstart + i) * 1024 + c8;
            float uc[8], g[8], y[8]; unpack8(*(const u32x4*)(U + off), uc); unpack8(*(const u32x4*)(GB + off), g);
#pragma unroll
            for (int e = 0; e < 8; ++e) { y[e] = g[e] * (w0[e] * um2[e] + w1[e] * um1[e] + w2[e] * uc[e]); um2[e] = um1[e]; um1[e] = uc[e]; }
            u32x4 w; w.x = pk2(y[0], y[1]); w.y = pk2(y[2], y[3]); w.z = pk2(y[4], y[5]); w.w = pk2(y[6], y[7]);
            *(u32x4*)(A2 + off) = w;
        }
    }
}

__device__ __forceinline__ void xcc_barrier(unsigned* bar, unsigned x, unsigned nloc) {
    asm volatile("s_waitcnt vmcnt(0)" ::: "memory");
    __syncthreads();
    if (threadIdx.x == 0) {
        __builtin_amdgcn_s_waitcnt(0);
        const unsigned old = xb_add(&bar[XB_XSUB(x)], 1u);
        const unsigned gen = old / nloc;
        if (old + 1u == (gen + 1u) * nloc) xb_add(&bar[XB_XGEN(x)], 1u);
        else XB_SPIN(xb_ld(&bar[XB_XGEN(x)]) == gen, bar);
        __builtin_amdgcn_fence(__ATOMIC_ACQUIRE, "agent");
        asm volatile("s_waitcnt vmcnt(0)" ::: "memory");
    }
    __syncthreads();
}

__device__ __forceinline__ void grid_seam() {
    asm volatile("s_waitcnt vmcnt(0) lgkmcnt(0)" ::: "memory");
    __syncthreads();
    cg::this_grid().sync();
    __builtin_amdgcn_fence(__ATOMIC_ACQUIRE, "agent");
    asm volatile("s_waitcnt vmcnt(0)" ::: "memory");
}
#ifndef MK_MULTI
#define MK_MULTI 0
#endif
#ifndef LAYER_STEPS
#define LAYER_STEPS {0, 1, 2, 3, 4, 5, 6}
#endif
__device__ const int LSTEP[] = LAYER_STEPS;
constexpr int NLS = sizeof(LSTEP) / sizeof(int);
#ifndef REP_PRO
#define REP_PRO 1
#endif
#ifndef REP_P0B
#define REP_P0B 1
#endif
__global__ void __launch_bounds__(NTHREADS, 2) mk_fwd(Args a) {
    extern __shared__ __attribute__((aligned(16))) unsigned char lds_raw[];
    LAS unsigned char* lds = (LAS unsigned char*)lds_raw;
    unsigned char* ws = a.ws;
    volatile LAS unsigned* bst = (volatile LAS unsigned*)(lds + 131072 + 512);
    if (threadIdx.x == 0) { bst[0] = 0u; bst[1] = 0u; }
    __syncthreads();
    {
        int tid = threadIdx.x; asm volatile("" : "+v"(tid)); const int lane = tid & 63, wid = __builtin_amdgcn_readfirstlane(tid >> 6);
#ifndef NO_P0A
        for (int rep = 0; rep < REP_PRO; ++rep) { p0a(a, lds, tid, lane, wid); __syncthreads(); }
#endif
        grid_seam();
    }
    if (threadIdx.x == 0) bst[2] = xb_add((unsigned*)(ws + WS_BARW) + XB_XCNT(xb_xcc_id()), 1u);
#define XBAR() do { XcdBarrier xb_; xb_.bar = (unsigned*)(ws + WS_BARW); xb_.x = xb_xcc_id(); xb_.st = bst; xcd_barrier(xb_); } while (0)
    {
        int tid = threadIdx.x; asm volatile("" : "+v"(tid)); const int lane = tid & 63, wid = __builtin_amdgcn_readfirstlane(tid >> 6);
#ifndef NO_P0B
        for (int rep = 0; rep < REP_P0B; ++rep) p0b(a, tid, lane, wid);
#endif
        XBAR();
    }
    if (threadIdx.x == 0) { unsigned* bw = (unsigned*)(ws + WS_BARW); bool reg = (gridDim.x == 256u);
        for (unsigned j = 0; j < 8; ++j) reg = reg && (xb_ld(&bw[XB_XCNT(j)]) == 32u);
#ifdef FORCE_GLOBAL
        reg = false;
#endif
        const unsigned x = xb_xcc_id();
        bst[3] = reg ? 1u : 0u; bst[4] = reg ? bst[2] * 8u + x : (unsigned)blockIdx.x; bst[5] = x; }
    __syncthreads();
    const float* xin = (const float*)a.in[0]; float* const outp = a.out;
    for (int it = 0; it < DEPTH * NLS; ++it) {
        unsigned char* ws = a.ws; asm volatile("" : "+s"(ws));
#define SLAB_EL ((size_t)12 * MiB)
#define TBASE(off_el, pitch, flat_el) (BST(3) ? BIG + (size_t)BST(5) * SLAB_EL + (size_t)(off_el) - (size_t)BST(5) * 4096 * (pitch) : BIG + (size_t)(flat_el))
#define T_ACT TBASE(0, DFF, 0)
#define T_Q   TBASE(0, 1024, 0)
#define T_K   TBASE(4 * MiB, 256, 32 * MiB)
#define T_V   TBASE(5 * MiB, 256, 40 * MiB)
#define T_ATT TBASE(6 * MiB, 1024, 48 * MiB)
#define T_U   TBASE(0, 1024, 0)
#define T_GB  TBASE(4 * MiB, 1024, (size_t)MROWS * 1024)
#define T_A2  TBASE(8 * MiB, 1024, (size_t)2 * MROWS * 1024)
#define BST(i) __builtin_amdgcn_readfirstlane((int)bst[i])
        float* rs = (float*)(ws + WS_RS); const float* sbt = (const float*)(ws + WS_SB);
        bf16_t* AP = (bf16_t*)(ws + WS_AP); bf16_t* BIG = (bf16_t*)(ws + WS_BIG);
        const float* GT = (const float*)(ws + WS_GT); const float* GATE = (const float*)(ws + WS_GATE);
        const float* par = (const float*)(ws + WS_PAR);
        int tid = threadIdx.x; asm volatile("" : "+v"(tid));
        const int lane = tid & 63, wid = __builtin_amdgcn_readfirstlane(tid >> 6);
        {
            const int l = it / NLS, k = LSTEP[it % NLS], s0 = 3 * l, jx = l >> 1;
            if (k == 0 || k == 5) {
                const int i = (k == 5), s = s0 + 2 * i;
                pg8::Gemm g{AP, (const bf16_t*)(ws + WS_UP) + (size_t)(2 * l + i) * NUP * 1024, MROWS, NUP, 1024};
                pg8::StaticOrder S; S.init(MROWS, NUP, gridDim.x, BST(4));
                pg8::EpiUp E{T_ACT, rs, sbt + (size_t)s * SB_STRIDE, (LAS float*)(lds + 131072 + 1024), -1};
                #ifndef NO_UP
                pg8::gemm_phase<pg8::EpiUp, pg8::StaticOrder, true, true>(lds, g, S, E, tid);
#endif
            } else if (k == 1 || k == 6 || k == 4) {
                pg8::Gemm g; pg8::EpiResid E;
                const int ridx = 3 * l + (k == 1 ? 0 : (k == 4 ? 1 : 2));
                bf16_t* const xs0 = (bf16_t*)(ws + WS_XALT); bf16_t* const xs1 = xs0 + (size_t)MROWS * 1024;
                E.out_f32 = (ridx == 3 * DEPTH - 1); E.base_f32 = (ridx == 0);
                E.out = E.out_f32 ? (void*)outp : (void*)((ridx & 1) ? xs1 : xs0); E.base = E.base_f32 ? (const void*)xin : (const void*)((ridx & 1) ? xs0 : xs1); E.AP = AP; E.bias = nullptr;
                if (k == 4) {
                    g = pg8::Gemm{(l & 1) ? T_A2 : T_ATT, (l & 1) ? (const bf16_t*)(ws + WS_COUT) + (size_t)jx * 1024 * 1024 : (const bf16_t*)(ws + WS_O) + (size_t)jx * 1024 * 1024, MROWS, 1024, 1024};
                    E.gate = GATE + (s0 + 1) * 16384; if (!(l & 1)) E.bias = par + PAR_BO + jx * 1024;
                    E.Gn = GT + (s0 + 2) * 16384; E.nrowss = rs;
                } else {
                    const int i = (k == 6);
                    g = pg8::Gemm{T_ACT, (const bf16_t*)(ws + WS_DN) + (size_t)(2 * l + i) * 1024 * DFF, MROWS, 1024, DFF};
                    E.gate = GATE + (s0 + 2 * i) * 16384;
                    if (!i) { E.Gn = GT + (s0 + 1) * 16384; E.nrowss = rs; }
                    else if (l < DEPTH - 1) { E.Gn = GT + (s0 + 3) * 16384; E.nrowss = rs; }
                    else { E.AP = nullptr; E.Gn = GT; E.nrowss = rs; }
                }
                pg8::StaticOrder S; S.init(MROWS, 1024, gridDim.x, BST(4));
                #ifndef NO_RES
                pg8::gemm_phase<pg8::EpiResid, pg8::StaticOrder, true, true>(lds, g, S, E, tid);
#endif
            } else if (k == 2) {
                if (!(l & 1)) {
                    pg8::Gemm g{AP, (const bf16_t*)(ws + WS_QKV) + (size_t)jx * NQKV * 1024, MROWS, NQKV, 1024};
                    pg8::StaticOrder S; S.init(MROWS, NQKV, gridDim.x, BST(4));
                    pg8::EpiQKV E{T_Q, T_K, T_V, rs, sbt + (size_t)(s0 + 1) * SB_STRIDE,
                                  par + PAR_QG + jx * 64, par + PAR_KG + jx * 64, (const float*)(ws + WS_COS), (const float*)(ws + WS_SIN)};
                    #ifndef NO_QKV
                    pg8::gemm_phase<pg8::EpiQKV, pg8::StaticOrder, true, true>(lds, g, S, E, tid);
#endif
                } else {
                    pg8::Gemm g{AP, (const bf16_t*)(ws + WS_CIN) + (size_t)jx * NCIN * 1024, MROWS, NCIN, 1024};
                    pg8::StaticOrder S; S.init(MROWS, NCIN, gridDim.x, BST(4));
                    pg8::EpiCin E{T_U, T_GB, rs, sbt + (size_t)(s0 + 1) * SB_STRIDE};
                    #ifndef NO_CIN
                    pg8::gemm_phase<pg8::EpiCin, pg8::StaticOrder, true, true>(lds, g, S, E, tid);
#endif
                }
            } else {
#ifndef NO_ATT
                if (!(l & 1)) attn_phase(lds, T_Q, T_K, T_V, T_ATT, par + PAR_SINK + jx * 16, tid, lane, wid, BST(3) ? BST(5) * 128 + (BST(4) >> 3) : (int)blockIdx.x, BST(3) ? BST(5) * 128 + 128 : NBATCH * 64, BST(3) ? 32 : (int)gridDim.x);
                else
#endif
#ifndef NO_CONV
                conv_phase(T_U, T_GB, T_A2, par + PAR_CW + jx * 3 * 1024, tid, BST(3) ? BST(5) * 64 + (BST(4) >> 3) : (int)blockIdx.x, BST(3) ? BST(5) * 64 + 64 : MROWS / 64, BST(3) ? 32 : (int)gridDim.x);
#endif
                ;
            }
        }
        if (it + 1 < DEPTH * NLS) { unsigned char* ws = a.ws; asm volatile("" : "+s"(ws));
            if (__builtin_amdgcn_readfirstlane((int)bst[3])) xcc_barrier((unsigned*)(ws + WS_BARW), (unsigned)__builtin_amdgcn_readfirstlane((int)bst[5]), 32u); else XBAR();
#ifdef DOUBLE_SEAM
            XBAR(); XBAR();
#endif
        }
    }
}

extern "C" void kernel_launch(void* const* d_in, const int* in_sizes, int n_in, void* d_out, int out_size, void* d_ws, size_t ws_size, hipStream_t stream) {
    static int grid = 0;
    if (grid == 0) {
        if (n_in != 18 || out_size != MROWS * DM || ws_size < WS_END) { fprintf(stderr, "kernel_launch: unexpected problem (n_in %d, out %d, ws %zu); nothing launched\n", n_in, out_size, ws_size); grid = -1; return; }
        int dev = 0, cus = 0, per_cu = 0;
        if (hipGetDevice(&dev) != hipSuccess || hipDeviceGetAttribute(&cus, hipDeviceAttributeMultiprocessorCount, dev) != hipSuccess) { grid = -1; return; }
        if (hipFuncSetAttribute((const void*)mk_fwd, hipFuncAttributeMaxDynamicSharedMemorySize, LDS_BYTES) != hipSuccess) { fprintf(stderr, "kernel_launch: hipFuncSetAttribute failed\n"); grid = -1; return; }
        if (hipOccupancyMaxActiveBlocksPerMultiprocessor(&per_cu, (const void*)mk_fwd, NTHREADS, LDS_BYTES) != hipSuccess || per_cu < 1) { fprintf(stderr, "kernel_launch: occupancy query says %d\n", per_cu); per_cu = 1; }
        (void)hipGetLastError();
        grid = cus * per_cu;
    }
    if (grid < 0) return;
    Args a{};
    for (int i = 0; i < 18; ++i) a.in[i] = d_in[i];
    a.out = (float*)d_out; a.ws = (unsigned char*)d_ws;
#if MK_MULTI
    for (int ph = 0; ph < NPH; ++ph) { a.ph_lo = ph; a.ph_hi = ph + 1; hipLaunchKernelGGL(mk_fwd, dim3(grid), dim3(NTHREADS), LDS_BYTES, stream, a); }
#else
    a.ph_lo = 0; a.ph_hi = NPH;
    void* args[] = {&a};
    hipError_t e = hipLaunchCooperativeKernel((const void*)mk_fwd, dim3(grid), dim3(NTHREADS), args, LDS_BYTES, stream);
    if (e != hipSuccess) fprintf(stderr, "cooperative launch failed: %s (grid %d)\n", hipGetErrorString(e), grid);
#endif
}
```

```cpp
#include <hip/hip_runtime.h>
#include <hip/hip_cooperative_groups.h>
#include <cstdio>
#include <cstdint>
namespace cg = cooperative_groups;
namespace pg8 {
#define PG8_LAS __attribute__((address_space(3)))
typedef unsigned short bf16_t;
typedef short bf16x8 __attribute__((ext_vector_type(8)));
typedef float f32x4 __attribute__((ext_vector_type(4)));
typedef unsigned u32x4 __attribute__((ext_vector_type(4)));
constexpr int BM = 256, BK = 64, HALF = 128, HTB = HALF * BK * 2  , STAGE_BYTES = 8 * HTB, NXCD = 8, WGM = 8;

__host__ __device__ __forceinline__ int lds_byte(int r, int c) { const int st = (r >> 4) * 2 + (c >> 5), rr = r & 15, cc = c & 31, ob = rr * 64 + cc * 2; return st * 1024 + (ob ^ (((ob >> 9) & 1) << 5)); }
__host__ __device__ __forceinline__ void stage_rc(int b, int& R, int& C) { const int st = b / 1024, sb = b % 1024, swz = sb ^ (((sb >> 9) & 1) << 5); R = (st >> 1) * 16 + swz / 64; C = (st & 1) * 32 + (swz % 64) / 2; }
__host__ __device__ __forceinline__ int perm32(int rho) { const int n = rho >> 4, i = rho & 15; return 8 * (i >> 2) + 4 * n + (i & 3); }

struct Unit { int pm, pn; };
struct Gemm { const bf16_t* A; const bf16_t* Bt; int M, N, K; };

struct StaticOrder {
    int nM, nN, nwg, G, c;
    __host__ __device__ void init(int M, int N, int G_, int c_) { nM = M / BM; nN = N / BM; nwg = nM * nN; G = G_; c = c_; }
    __host__ __device__ bool next(int i, Unit& u) const {
        const long L = (long)i * G + c; if (L >= nwg) return false;
        int wgid = (int)L; { const int q = nwg / NXCD, r = nwg % NXCD, xcd = wgid % NXCD, off = wgid / NXCD; wgid = (xcd < r ? xcd * (q + 1) : r * (q + 1) + (xcd - r) * q) + off; }
        const int nig = WGM * nN, gid = wgid / nig, fm = gid * WGM, gsz = (nM - fm) < WGM ? (nM - fm) : WGM;
        u.pm = fm + ((wgid % nig) % gsz); u.pn = (wgid % nig) / gsz; return true;
    }
    __device__ __forceinline__ void a_ready(const Unit&) const {}
    __device__ __forceinline__ void done(const Unit&) const {}
};

typedef float f32x2 __attribute__((ext_vector_type(2)));
typedef __bf16 bf16x2_t __attribute__((ext_vector_type(2)));
__device__ __forceinline__ unsigned cvt_pk_bf16(float lo, float hi) { const f32x2 v = {lo, hi}; const bf16x2_t b = __builtin_convertvector(v, bf16x2_t); return __builtin_bit_cast(unsigned, b); }
typedef unsigned u32x2 __attribute__((ext_vector_type(2)));
#define PG8_GAS __attribute__((address_space(1)))
__device__ __forceinline__ f32x4 ld4(const float* p) { return *(const PG8_GAS f32x4*)p; }
__device__ __forceinline__ u32x4 ld4u(const void* p) { return *(const PG8_GAS u32x4*)p; }
__device__ __forceinline__ void st4f(float* p, f32x4 v) { *(PG8_GAS f32x4*)p = v; }
__device__ __forceinline__ void st4u(void* p, u32x4 v) { *(PG8_GAS u32x4*)p = v; }
__device__ __forceinline__ u32x4 pack8(f32x4 a, f32x4 b) { u32x4 w; w.x = cvt_pk_bf16(a[0], a[1]); w.y = cvt_pk_bf16(a[2], a[3]); w.z = cvt_pk_bf16(b[0], b[1]); w.w = cvt_pk_bf16(b[2], b[3]); return w; }
__device__ __forceinline__ float silu_f(float g) { return g * __builtin_amdgcn_rcpf(1.f + __builtin_amdgcn_exp2f(-1.44269504f * g)); }
__device__ __forceinline__ float rstd_of(float ss, float inv_n) { return 1.0f / sqrtf(ss * inv_n + 1e-6f); }
__device__ __forceinline__ float rstd_row(const float* rsp, int row) {
    const f32x4 a = ld4(rsp + (size_t)row * 16), b = ld4(rsp + (size_t)row * 16 + 4), c = ld4(rsp + (size_t)row * 16 + 8), d = ld4(rsp + (size_t)row * 16 + 12);
    const float s = (((a[0] + a[1]) + (a[2] + a[3])) + ((b[0] + b[1]) + (b[2] + b[3]))) + (((c[0] + c[1]) + (c[2] + c[3])) + ((d[0] + d[1]) + (d[2] + d[3])));
    return rstd_of(s, 1.f / 1024.f);
}

__device__ __forceinline__ void rstd8(const float* rsp, int row0, int fq, float (&r)[2][4]) {
    f32x4 p[2][4];
#pragma unroll
    for (int ai = 0; ai < 2; ++ai)
#pragma unroll
        for (int m = 0; m < 4; ++m) p[ai][m] = ld4(rsp + (size_t)(row0 + ai * 128 + m * 16) * 16 + 4 * fq);
#pragma unroll
    for (int ai = 0; ai < 2; ++ai)
#pragma unroll
        for (int m = 0; m < 4; ++m) { float s = (p[ai][m][0] + p[ai][m][1]) + (p[ai][m][2] + p[ai][m][3]); s += __shfl_xor(s, 16); s += __shfl_xor(s, 32);
            r[ai][m] = __builtin_amdgcn_rsqf(s * (1.f / 1024.f) + 1e-6f); }
}

struct EpiUp {
    static constexpr bool PERM = true, AFTER_DRAIN = false;
    bf16_t* O; const float* rowss; const float* sb; PG8_LAS float* rl; mutable int last_pm;
    __device__ __forceinline__ void operator()(const f32x4 (&acc)[2][2][4][2], const Unit& u, int wr, int wc, int fr, int fq) const {
        const int b = u.pm >> 3;
        const float* sbp = sb + (size_t)b * 5632 + u.pn * 256 + wc * 32 + 8 * fq;
        f32x4 sg[2], su[2];
#pragma unroll
        for (int n = 0; n < 2; ++n) { sg[n] = ld4(sbp + 4 * n); su[n] = ld4(sbp + 128 + 4 * n); }
        const int row0 = u.pm * 256 + wr * 64 + fr;
        bf16_t* ob = O + u.pn * 128 + wc * 32 + 8 * fq;
        float rr[2][4];
        PG8_LAS float* rw = rl + (wr * 4 + wc) * 128 + fr;
        if (u.pm != last_pm) {
            rstd8(rowss, row0, fq, rr);
            if (fq == 0) {
#pragma unroll
                for (int ai = 0; ai < 2; ++ai)
#pragma unroll
                    for (int m = 0; m < 4; ++m) rw[(ai * 4 + m) * 16] = rr[ai][m]; }
            last_pm = u.pm;
        } else {
#pragma unroll
            for (int ai = 0; ai < 2; ++ai)
#pragma unroll
                for (int m = 0; m < 4; ++m) rr[ai][m] = rw[(ai * 4 + m) * 16];
        }
#pragma unroll
        for (int ai = 0; ai < 2; ++ai)
#pragma unroll
            for (int m = 0; m < 4; ++m) {
                const int row = row0 + ai * 128 + m * 16; const float r = rr[ai][m]; const f32x2 r2 = {r, r};
                u32x4 w;
#pragma unroll
                for (int n = 0; n < 2; ++n) { const f32x4 ga = acc[ai][0][m][n], ua = acc[ai][1][m][n];
#pragma unroll
                    for (int h = 0; h < 2; ++h) {
                        const f32x2 g2 = (f32x2){ga[2 * h], ga[2 * h + 1]} * r2 + (f32x2){sg[n][2 * h], sg[n][2 * h + 1]};
                        const f32x2 u2 = (f32x2){ua[2 * h], ua[2 * h + 1]} * r2 + (f32x2){su[n][2 * h], su[n][2 * h + 1]};
                        const f32x2 t2 = g2 * (-1.44269504f);
                        f32x2 d2; d2.x = __builtin_amdgcn_exp2f(t2.x); d2.y = __builtin_amdgcn_exp2f(t2.y); d2 = d2 + 1.0f;
                        f32x2 q2; q2.x = __builtin_amdgcn_rcpf(d2.x); q2.y = __builtin_amdgcn_rcpf(d2.y);
                        const f32x2 a2 = (g2 * u2) * q2;
                        w[2 * n + h] = cvt_pk_bf16(a2.x, a2.y); } }
                st4u(ob + (size_t)row * 2816, w);
            }
    }
};

__device__ __forceinline__ f32x4 bf4_lo(u32x4 w) { f32x4 r; r[0] = __builtin_bit_cast(float, w[0] << 16); r[1] = __builtin_bit_cast(float, w[0] & 0xffff0000u); r[2] = __builtin_bit_cast(float, w[1] << 16); r[3] = __builtin_bit_cast(float, w[1] & 0xffff0000u); return r; }
__device__ __forceinline__ f32x4 bf4_hi(u32x4 w) { f32x4 r; r[0] = __builtin_bit_cast(float, w[2] << 16); r[1] = __builtin_bit_cast(float, w[2] & 0xffff0000u); r[2] = __builtin_bit_cast(float, w[3] << 16); r[3] = __builtin_bit_cast(float, w[3] & 0xffff0000u); return r; }
struct EpiResid {
    static constexpr bool PERM = true, AFTER_DRAIN = false;
    const void* base; void* out; int base_f32, out_f32; const float* gate; const float* bias;
    bf16_t* AP; const float* Gn; float* nrowss;
    __device__ __forceinline__ void operator()(const f32x4 (&acc)[2][2][4][2], const Unit& u, int wr, int wc, int fr, int fq) const {
        const int b = u.pm >> 3;
        const int col0 = u.pn * 256 + wc * 32 + 8 * fq;
        f32x4 gt[2][2], bs[2][2], G[2][2];
#pragma unroll
        for (int bj = 0; bj < 2; ++bj)
#pragma unroll
            for (int n = 0; n < 2; ++n) { const int c = col0 + 128 * bj + 4 * n;
                gt[bj][n] = ld4(gate + b * 1024 + c);
                bs[bj][n] = bias ? ld4(bias + c) : (f32x4){0.f, 0.f, 0.f, 0.f};
                G[bj][n] = AP ? ld4(Gn + b * 1024 + c) : (f32x4){0.f, 0.f, 0.f, 0.f}; }
        const int row0 = u.pm * 256 + wr * 64 + fr;
#pragma unroll
        for (int ai = 0; ai < 2; ++ai)
#pragma unroll
            for (int m = 0; m < 4; ++m) {
                const int row = row0 + ai * 128 + m * 16; const size_t off = (size_t)row * 1024 + col0; float ss = 0.f;
#pragma unroll
                for (int bj = 0; bj < 2; ++bj) { f32x4 xin[2], xn[2];
                    if (base_f32) { xin[0] = ld4((const float*)base + off + 128 * bj); xin[1] = ld4((const float*)base + off + 128 * bj + 4); }
                    else { const u32x4 w = ld4u((const bf16_t*)base + off + 128 * bj); xin[0] = bf4_lo(w); xin[1] = bf4_hi(w); }
#pragma unroll
                    for (int n = 0; n < 2; ++n) { xn[n] = xin[n] + gt[bj][n] * (acc[ai][bj][m][n] + bs[bj][n]);
                        ss += (xn[n][0] * xn[n][0] + xn[n][1] * xn[n][1]) + (xn[n][2] * xn[n][2] + xn[n][3] * xn[n][3]); }
                    if (out_f32) { st4f((float*)out + off + 128 * bj, xn[0]); st4f((float*)out + off + 128 * bj + 4, xn[1]); }
                    else st4u((bf16_t*)out + off + 128 * bj, pack8(xn[0], xn[1]));
                    if (AP) st4u(AP + off + 128 * bj, pack8(xn[0] * G[bj][0], xn[1] * G[bj][1])); }
                if (AP) { ss += __shfl_xor(ss, 16); ss += __shfl_xor(ss, 32); if (fq == 0) *(PG8_GAS float*)(nrowss + (size_t)row * 16 + u.pn * 4 + wc) = ss; }
                if (m & 1) asm volatile("" ::: "memory");
            }
    }
};

struct EpiQKV {
    static constexpr bool PERM = true, AFTER_DRAIN = false;
    bf16_t *Q, *K, *V; const float* rowss; const float* sb; const float* qg; const float* kg; const float* cosT; const float* sinT;
    __device__ __forceinline__ void operator()(const f32x4 (&acc)[2][2][4][2], const Unit& u, int wr, int wc, int fr, int fq) const {
        const int b = u.pm >> 3;
        const float* sbp = sb + (size_t)b * 1536 + u.pn * 256 + wc * 32 + 8 * fq;
        f32x4 sv[2][2], gv[2][2];
        const int typ = u.pn < 4 ? 0 : (u.pn == 4 ? 1 : 2);
        const float* gp = (typ == 0 ? qg : kg) + 8 * fq;
#pragma unroll
        for (int bj = 0; bj < 2; ++bj)
#pragma unroll
            for (int n = 0; n < 2; ++n) { sv[bj][n] = ld4(sbp + 128 * bj + 4 * n); gv[bj][n] = ld4(gp + 32 * bj + 4 * n); }
        const int row0 = u.pm * 256 + wr * 64 + fr;
        float rr[2][4]; rstd8(rowss, row0, fq, rr);
        bf16_t* dst; int pitch; float osc = 1.f;
        if (typ == 0) { dst = Q + (u.pn * 4 + wc) * 64 + 8 * fq; pitch = 1024; osc = 0.125f * 1.44269504f; }
        else if (typ == 1) { dst = K + wc * 64 + 8 * fq; pitch = 256; }
        else { dst = V + wc * 64 + 8 * fq; pitch = 256; }
#pragma unroll
        for (int ai = 0; ai < 2; ++ai)
#pragma unroll
            for (int m = 0; m < 4; ++m) {
                const int row = row0 + ai * 128 + m * 16; const float r = rr[ai][m];
                f32x4 v[2][2]; float ss = 0.f;
#pragma unroll
                for (int bj = 0; bj < 2; ++bj)
#pragma unroll
                    for (int n = 0; n < 2; ++n) { v[bj][n] = acc[ai][bj][m][n] * r + sv[bj][n];
                        ss += (v[bj][n][0] * v[bj][n][0] + v[bj][n][1] * v[bj][n][1]) + (v[bj][n][2] * v[bj][n][2] + v[bj][n][3] * v[bj][n][3]); }
                bf16_t* dp = dst + (size_t)row * pitch;
                if (typ == 2) {
                    st4u(dp, pack8(v[0][0], v[0][1])); st4u(dp + 32, pack8(v[1][0], v[1][1]));
                } else {
                    ss += __shfl_xor(ss, 16); ss += __shfl_xor(ss, 32);
                    const float rn = rstd_of(ss, 1.f / 64.f) * osc;
                    f32x4 o1[2], o2[2];
#pragma unroll
                    for (int n = 0; n < 2; ++n) { const f32x4 cs = ld4(cosT + (size_t)row * 32 + 8 * fq + 4 * n), sn = ld4(sinT + (size_t)row * 32 + 8 * fq + 4 * n);
                        const f32x4 y1 = v[0][n] * gv[0][n] * rn, y2 = v[1][n] * gv[1][n] * rn;
                        o1[n] = y1 * cs - y2 * sn; o2[n] = y2 * cs + y1 * sn; }
                    st4u(dp, pack8(o1[0], o1[1])); st4u(dp + 32, pack8(o2[0], o2[1]));
                }
            }
    }
};

struct EpiCin {
    static constexpr bool PERM = true, AFTER_DRAIN = false;
    bf16_t *U, *GB; const float* rowss; const float* sb;
    __device__ __forceinline__ void operator()(const f32x4 (&acc)[2][2][4][2], const Unit& u, int wr, int wc, int fr, int fq) const {
        const int b = u.pm >> 3;
        const float* sbp = sb + (size_t)b * 3072 + u.pn * 256 + wc * 32 + 8 * fq;
        f32x4 sv[2][2];
#pragma unroll
        for (int bj = 0; bj < 2; ++bj)
#pragma unroll
            for (int n = 0; n < 2; ++n) sv[bj][n] = ld4(sbp + 128 * bj + 4 * n);
        const int row0 = u.pm * 256 + wr * 64 + fr;
        float rr[2][4]; rstd8(rowss, row0, fq, rr);
        const bool isu = u.pn < 8;
        bf16_t* ob = isu ? U + u.pn * 128 + wc * 32 + 8 * fq : GB + (u.pn - 8) * 256 + wc * 32 + 8 * fq;
#pragma unroll
        for (int ai = 0; ai < 2; ++ai)
#pragma unroll
            for (int m = 0; m < 4; ++m) {
                const int row = row0 + ai * 128 + m * 16; const float r = rr[ai][m];
                f32x4 v[2][2];
#pragma unroll
                for (int bj = 0; bj < 2; ++bj)
#pragma unroll
                    for (int n = 0; n < 2; ++n) v[bj][n] = acc[ai][bj][m][n] * r + sv[bj][n];
                bf16_t* dp = ob + (size_t)row * 1024;
                if (isu) { st4u(dp, pack8(v[0][0] * v[1][0], v[0][1] * v[1][1])); }
                else { st4u(dp, pack8(v[0][0], v[0][1])); st4u(dp + 128, pack8(v[1][0], v[1][1])); }
            }
    }
};


struct StaticOrderPF : StaticOrder {
    const float* pbase; PG8_LAS unsigned char* dummy; int ptid;
    __device__ __forceinline__ void a_ready(const Unit& u) const {
#ifdef NO_PF
        return;
#endif
        const char* p = (const char*)pbase + ((size_t)(u.pm * 256) * 1024 + u.pn * 256) * 4;
#pragma unroll
        for (int i = 0; i < 4; ++i) { const int line = ptid + 512 * i;
            __builtin_amdgcn_global_load_lds((const unsigned*)(p + (size_t)(line >> 3) * 4096 + (line & 7) * 128), (PG8_LAS unsigned*)dummy, 4, 0, 0); }
    }
};
template <class Epi, class Sched, bool ALIGN_EPI = false, bool SP2 = false>
__device__ __forceinline__ void gemm_phase(PG8_LAS unsigned char* lds, const Gemm g, const Sched& S, const Epi& E, const int tid_in) {
    const int tid = tid_in, wid = __builtin_amdgcn_readfirstlane(tid >> 6), lane = tid & 63, wr = wid >> 2, wc = wid & 3, fr = lane & 15, fq = lane >> 4;
    const int K = g.K, nt = K / BK;
    unsigned voffA[2], voffB[2];
#pragma unroll
    for (int i = 0; i < 2; ++i) { int R, C; stage_rc(tid * 16 + i * 8192, R, C); const int Rb = Epi::PERM ? ((R & ~31) + perm32(R & 31)) : R;
        voffA[i] = (unsigned)(R * K + C) * 2u; voffB[i] = (unsigned)(Rb * K + C) * 2u; }
    const size_t kstep = (size_t)(BK * 2);
    const size_t hstep = (size_t)HALF * K * 2;
    const size_t tstep = 2 * hstep;
    const unsigned ldsw = (unsigned)wid * 1024u;
    const int aoff = lds_byte(wr * 64 + fr, fq * 8), boff = lds_byte(wc * 32 + fr, fq * 8);
#define PG8_SA(b, h) (((b) * 2 + (h)) * HTB)
#define PG8_SB(b, h) ((4 + (b) * 2 + (h)) * HTB)
#define PG8_STAGE(bufoff, gbase, voff) do { _Pragma("unroll") for (int _i = 0; _i < 2; ++_i) \
        __builtin_amdgcn_global_load_lds((const unsigned*)((const char*)(gbase) + (voff)[_i]), (PG8_LAS unsigned*)(lds + (bufoff) + ldsw + _i * 8192), 16, 0, 0); } while (0)
#define PG8_LDA(dst, b, h) do { _Pragma("unroll") for (int m = 0; m < 4; ++m) _Pragma("unroll") for (int k = 0; k < 2; ++k) dst[m][k] = *(const PG8_LAS bf16x8*)(lds + PG8_SA(b, h) + aoff + m * 2048 + k * 1024); } while (0)
#define PG8_LDB(dst, b, h) do { _Pragma("unroll") for (int n = 0; n < 2; ++n) _Pragma("unroll") for (int k = 0; k < 2; ++k) dst[n][k] = *(const PG8_LAS bf16x8*)(lds + PG8_SB(b, h) + boff + n * 2048 + k * 1024); } while (0)
#define PG8_MMA(ai, bj, At, Bt) do { __builtin_amdgcn_s_setprio(1); _Pragma("unroll") for (int m = 0; m < 4; ++m) _Pragma("unroll") for (int n = 0; n < 2; ++n) _Pragma("unroll") for (int k = 0; k < 2; ++k) \
        acc[ai][bj][m][n] = __builtin_amdgcn_mfma_f32_16x16x32_bf16(Bt[n][k], At[m][k], acc[ai][bj][m][n], 0, 0, 0); __builtin_amdgcn_s_setprio(0); } while (0)
#define PG8_WAIT_V(n) asm volatile("s_waitcnt vmcnt(" #n ")" ::: "memory")
#define PG8_WAIT_L(n) asm volatile("s_waitcnt lgkmcnt(" #n ")" ::: "memory")
#define PG8_BAR __builtin_amdgcn_s_barrier()
#define PG8_SCHED __builtin_amdgcn_sched_barrier(0)
    Unit cur, nxt; int ui = 0;
    if (!S.next(0, cur)) return;
    f32x4 acc[2][2][4][2];
#pragma unroll
    for (int a = 0; a < 2; ++a)
#pragma unroll
        for (int b = 0; b < 2; ++b)
#pragma unroll
            for (int m = 0; m < 4; ++m)
#pragma unroll
                for (int n = 0; n < 2; ++n) acc[a][b][m][n] = (f32x4){0.f, 0.f, 0.f, 0.f};
    bf16x8 At[4][2], B0[2][2], B1[2][2];
    const char* cA = (const char*)g.A + (size_t)cur.pm * tstep; const char* cB = (const char*)g.Bt + (size_t)cur.pn * tstep;
    S.a_ready(cur);
    if constexpr (SP2) {
        PG8_STAGE(PG8_SB(0, 0), cB, voffB); PG8_STAGE(PG8_SB(0, 1), cB + hstep, voffB); PG8_STAGE(PG8_SA(0, 0), cA, voffA); PG8_STAGE(PG8_SA(0, 1), cA + hstep, voffA);
        if (wr == 1) PG8_BAR;
        PG8_WAIT_V(2); PG8_BAR;
        PG8_STAGE(PG8_SB(1, 0), cB + kstep, voffB); PG8_STAGE(PG8_SA(1, 0), cA + kstep, voffA); PG8_STAGE(PG8_SB(1, 1), cB + hstep + kstep, voffB);
        PG8_WAIT_V(6); PG8_BAR;
    } else {
        PG8_STAGE(PG8_SB(0, 0), cB, voffB); PG8_STAGE(PG8_SA(0, 0), cA, voffA); PG8_STAGE(PG8_SB(0, 1), cB + hstep, voffB); PG8_STAGE(PG8_SA(0, 1), cA + hstep, voffA);
        if (wr == 1) PG8_BAR;
        PG8_WAIT_V(4); PG8_BAR;
        PG8_STAGE(PG8_SB(1, 0), cB + kstep, voffB); PG8_STAGE(PG8_SA(1, 0), cA + kstep, voffA); PG8_STAGE(PG8_SB(1, 1), cB + hstep + kstep, voffB);
        PG8_WAIT_V(6); PG8_BAR;
    }
    for (;;) {
        const bool has_next = S.next(ui + 1, nxt);
        const char* nA = has_next ? (const char*)g.A + (size_t)nxt.pm * tstep : cA; const char* nB = has_next ? (const char*)g.Bt + (size_t)nxt.pn * tstep : cB;
        for (int t = 0; t < nt; t += 2) {
            const bool last = (t == nt - 2);
            const char* a1 = cA + (size_t)(t + 1) * kstep;
            const char* a2 = last ? nA : cA + (size_t)(t + 2) * kstep; const char* b2 = last ? nB : cB + (size_t)(t + 2) * kstep;
            const char* a3 = a2 + kstep; const char* b3 = b2 + kstep;
            if (last && has_next) S.a_ready(nxt);
            if constexpr (SP2) {
            PG8_LDB(B0, 0, 0); PG8_LDB(B1, 0, 1); PG8_SCHED; PG8_LDA(At, 0, 0); PG8_STAGE(PG8_SA(1, 1), a1 + hstep, voffA);
            PG8_WAIT_V(8); PG8_WAIT_L(0); PG8_BAR; PG8_MMA(0, 0, At, B0); PG8_MMA(0, 1, At, B1); PG8_BAR; PG8_SCHED;
            PG8_LDA(At, 0, 1); PG8_STAGE(PG8_SB(0, 0), b2, voffB); PG8_STAGE(PG8_SB(0, 1), b2 + hstep, voffB); PG8_STAGE(PG8_SA(0, 0), a2, voffA);
            PG8_WAIT_V(8); PG8_WAIT_L(0); PG8_BAR; PG8_MMA(1, 0, At, B0); PG8_MMA(1, 1, At, B1); PG8_BAR; PG8_SCHED;
            PG8_LDB(B0, 1, 0); PG8_LDB(B1, 1, 1); PG8_SCHED; PG8_LDA(At, 1, 0); PG8_STAGE(PG8_SA(0, 1), a2 + hstep, voffA);
            PG8_WAIT_V(8); PG8_WAIT_L(0); PG8_BAR; PG8_MMA(0, 0, At, B0); PG8_MMA(0, 1, At, B1); PG8_BAR; PG8_SCHED;
            PG8_LDA(At, 1, 1); PG8_STAGE(PG8_SB(1, 0), b3, voffB); PG8_STAGE(PG8_SB(1, 1), b3 + hstep, voffB); PG8_STAGE(PG8_SA(1, 0), a3, voffA);
            PG8_WAIT_V(8); PG8_WAIT_L(0); PG8_BAR; PG8_MMA(1, 0, At, B0); PG8_MMA(1, 1, At, B1); PG8_BAR; PG8_SCHED;
            } else {
            PG8_LDB(B0, 0, 0); PG8_SCHED; PG8_LDA(At, 0, 0); PG8_STAGE(PG8_SA(1, 1), a1 + hstep, voffA);
            PG8_WAIT_L(8); PG8_BAR; PG8_WAIT_L(0); PG8_MMA(0, 0, At, B0); PG8_BAR; PG8_SCHED;
            PG8_LDB(B1, 0, 1); PG8_STAGE(PG8_SB(0, 0), b2, voffB);
            PG8_BAR; PG8_WAIT_L(0); PG8_MMA(0, 1, At, B1); PG8_BAR;
            PG8_LDA(At, 0, 1); PG8_STAGE(PG8_SA(0, 0), a2, voffA);
            PG8_BAR; PG8_WAIT_L(0); PG8_MMA(1, 0, At, B0); PG8_BAR; PG8_SCHED;
            PG8_STAGE(PG8_SB(0, 1), b2 + hstep, voffB);
            PG8_WAIT_V(6); PG8_BAR; PG8_MMA(1, 1, At, B1); PG8_BAR;
            PG8_LDB(B0, 1, 0); PG8_SCHED; PG8_LDA(At, 1, 0); PG8_STAGE(PG8_SA(0, 1), a2 + hstep, voffA);
            PG8_WAIT_L(8); PG8_BAR; PG8_WAIT_L(0); PG8_MMA(0, 0, At, B0); PG8_BAR; PG8_SCHED;
            PG8_LDB(B1, 1, 1); PG8_STAGE(PG8_SB(1, 0), b3, voffB);
            PG8_BAR; PG8_WAIT_L(0); PG8_MMA(0, 1, At, B1); PG8_BAR;
            PG8_LDA(At, 1, 1); PG8_STAGE(PG8_SA(1, 0), a3, voffA);
            PG8_BAR; PG8_WAIT_L(0); PG8_MMA(1, 0, At, B0); PG8_BAR; PG8_SCHED;
            PG8_STAGE(PG8_SB(1, 1), b3 + hstep, voffB);
            PG8_WAIT_V(6); PG8_BAR; PG8_MMA(1, 1, At, B1); PG8_BAR;
            }
        }
        if constexpr (ALIGN_EPI) { if (wr == 0) PG8_BAR; }
        if constexpr (!Epi::AFTER_DRAIN) { E(acc, cur, wr, wc, fr, fq); S.done(cur); }
        if (!has_next) break;
#pragma unroll
        for (int a = 0; a < 2; ++a)
#pragma unroll
            for (int b = 0; b < 2; ++b)
#pragma unroll
                for (int m = 0; m < 4; ++m)
#pragma unroll
                    for (int n = 0; n < 2; ++n) acc[a][b][m][n] = (f32x4){0.f, 0.f, 0.f, 0.f};
        cur = nxt; cA = nA; cB = nB; ++ui;
        if constexpr (ALIGN_EPI) { if (wr == 1) PG8_BAR; }
    }
    PG8_WAIT_V(0);
    if constexpr (!ALIGN_EPI) { if (wr == 0) PG8_BAR; }
    PG8_BAR;
    if constexpr (Epi::AFTER_DRAIN) { E.fused(acc, cur, wr, wc, fr, fq, lds, wid, lane); S.done(cur); }
#undef PG8_SA
#undef PG8_SB
#undef PG8_STAGE
#undef PG8_LDA
#undef PG8_LDB
#undef PG8_MMA
#undef PG8_WAIT_V
#undef PG8_WAIT_L
#undef PG8_BAR
#undef PG8_SCHED
}
}

#define LAS __attribute__((address_space(3)))
typedef pg8::bf16_t bf16_t;
typedef short bf16x8 __attribute__((ext_vector_type(8)));
typedef short s16x4 __attribute__((ext_vector_type(4)));
typedef float f32x4 __attribute__((ext_vector_type(4)));
typedef float f32x16 __attribute__((ext_vector_type(16)));
typedef unsigned u32x4 __attribute__((ext_vector_type(4)));
typedef unsigned u32x2 __attribute__((ext_vector_type(2)));

constexpr int DM = 1024, NBATCH = 16, SEQ = 2048, MROWS = NBATCH * SEQ, DFF = 2816, NUP = 2 * DFF, NQKV = 1536, NCIN = 3072, NADA = 9 * DM, DEPTH = 4;
constexpr int NWAVES = 8, NTHREADS = NWAVES * 64;
constexpr int LDS_BYTES = 131072 + 1024 + 4096;
constexpr size_t MiB = 1u << 20;
constexpr size_t WS_UP = 0, WS_DN = 88 * MiB, WS_QKV = 132 * MiB, WS_O = 138 * MiB, WS_CIN = 142 * MiB, WS_COUT = 154 * MiB;
constexpr size_t WS_MOD = 158 * MiB, WS_SB = 161 * MiB, WS_RS = 166 * MiB, WS_COS = 168 * MiB, WS_SIN = 172 * MiB, WS_GT = 176 * MiB, WS_GATE = 177 * MiB, WS_AP = 178 * MiB, WS_BIG = 242 * MiB, WS_XALT = 434 * MiB, WS_END = 562 * MiB;
constexpr size_t WS_PAR = 177 * MiB + 768 * 1024;
constexpr int PAR_BO = 0, PAR_QG = 2048, PAR_KG = 2176, PAR_SINK = 2304, PAR_CW = 2336, PAR_N = 2336 + 6144;
constexpr size_t WS_BARW = WS_PAR + 64 * 1024;
constexpr size_t SB_STRIDE = (size_t)16 * NUP;
constexpr int NPH = 2 + 7 * DEPTH;

struct Args { const void* in[18]; float* out; unsigned char* ws; int ph_lo, ph_hi; };

__device__ const float INVF[32] = {1.0f, 0.7498942613601685f, 0.5623413324356079f, 0.4216965138912201f, 0.3162277638912201f, 0.23713737726211548f, 0.17782793939113617f, 0.133352130651474f,
    0.10000000149011612f, 0.07498941570520401f, 0.05623413249850273f, 0.04216965287923813f, 0.03162277489900589f, 0.023713737726211548f, 0.017782794311642647f, 0.01333521492779255f,
    0.009999999776482582f, 0.007498941849917173f, 0.005623413249850273f, 0.0042169648222625256f, 0.003162277629598975f, 0.00237137358635664f, 0.0017782794311642647f, 0.0013335214462131262f,
    0.0010000000474974513f, 0.0007498942431993783f, 0.000562341301701963f, 0.0004216965171508491f, 0.0003162277571391314f, 0.00023713737027719617f, 0.00017782794020604342f, 0.0001333521504420787f};

#define LDS_WAIT() asm volatile("s_waitcnt lgkmcnt(0)" ::: "memory")
__device__ __forceinline__ unsigned f2bf(float f) { unsigned u = __builtin_bit_cast(unsigned, f); return (u + 0x7fffu + ((u >> 16) & 1u)) >> 16; }
__device__ __forceinline__ unsigned pk2(float lo, float hi) { return f2bf(lo) | (f2bf(hi) << 16); }
__device__ __forceinline__ float bf_lo(unsigned w) { return __builtin_bit_cast(float, w << 16); }
__device__ __forceinline__ float bf_hi(unsigned w) { return __builtin_bit_cast(float, w & 0xffff0000u); }
__device__ __forceinline__ float wave_sum(float v) {
#pragma unroll
    for (int o = 1; o < 64; o <<= 1) v += __shfl_xor(v, o);
    return v;
}

#define RLX_AGENT __ATOMIC_RELAXED, __HIP_MEMORY_SCOPE_AGENT
#define XB_TMO      128
#define XB_XCNT(j)  (256  + 64 * (j))
#define XB_XSUB(j)  (1280 + 64 * (j))
#define XB_XGEN(j)  (2304 + 64 * (j))
#define XB_TOP      3328
#define XB_TOPGEN   3392
#define XCD_BAR_WORDS 3456
#define XB_SPIN_CAP (1u << 18)

__device__ __forceinline__ unsigned xb_ld(unsigned* p)              { return __hip_atomic_load(p, __ATOMIC_RELAXED, __HIP_MEMORY_SCOPE_AGENT); }
__device__ __forceinline__ unsigned xb_add(unsigned* p, unsigned v) { return __hip_atomic_fetch_add(p, v, __ATOMIC_RELAXED, __HIP_MEMORY_SCOPE_AGENT); }
__device__ __forceinline__ unsigned xb_xcc_id() { return (unsigned)__builtin_amdgcn_s_getreg((3 << 11) | 20) & 0xFu; }
#define XB_SPIN(cond, bar) do { unsigned _sp = 0; while (cond) { __builtin_amdgcn_s_sleep(1); \
    if ((++_sp & 255u) == 0u) { if (xb_ld(&(bar)[XB_TMO])) break; if (_sp > XB_SPIN_CAP) { atomicAdd(&(bar)[XB_TMO], 1u); break; } } } } while (0)

struct XcdBarrier {
    unsigned* bar; unsigned x;
    volatile LAS unsigned* st;
};

__device__ __forceinline__ XcdBarrier xcd_barrier_post(unsigned* bar, volatile LAS unsigned* st) {
    XcdBarrier b; b.bar = bar; b.x = xb_xcc_id(); b.st = st;
    if (threadIdx.x == 0) (void)xb_add(&bar[XB_XCNT(b.x)], 1u);
    return b;
}
__device__ __forceinline__ void xcd_barrier_complete(unsigned* bar, unsigned x, unsigned& nloc, unsigned& nx) {
    const unsigned G = gridDim.x * gridDim.y * gridDim.z;
    unsigned sum, cnt, mine, sp = 0u;
    for (;;) {
        sum = 0u; cnt = 0u; mine = 0u;
#pragma unroll
        for (unsigned j = 0; j < 16; ++j) { const unsigned c = xb_ld(&bar[XB_XCNT(j)]); sum += c; cnt += (c > 0u) ? 1u : 0u; mine = (j == x) ? c : mine; }
        if (sum == G) break;
        __builtin_amdgcn_s_sleep(1);
        if ((++sp & 255u) == 0u) { if (xb_ld(&bar[XB_TMO])) break; if (sp > XB_SPIN_CAP) { atomicAdd(&bar[XB_TMO], 1u); break; } }
    }
    nloc = mine > 0u ? mine : 1u; nx = cnt > 0u ? cnt : 1u;
}

__device__ __forceinline__ void xcd_barrier(const XcdBarrier& b) {
    asm volatile("s_waitcnt vmcnt(0)" ::: "memory");
    __syncthreads();
    if (threadIdx.x == 0) {
        unsigned* bar = b.bar;
        __builtin_amdgcn_s_waitcnt(0);
        unsigned nloc = b.st[0], nx = b.st[1];
        if (nloc == 0u) { xcd_barrier_complete(bar, b.x, nloc, nx); b.st[0] = nloc; b.st[1] = nx; }
        const unsigned old = xb_add(&bar[XB_XSUB(b.x)], 1u);
        const unsigned gen = old / nloc;
        if (old + 1u == (gen + 1u) * nloc) {
            __builtin_amdgcn_fence(__ATOMIC_RELEASE, "agent");
            asm volatile("s_waitcnt vmcnt(0)" ::: "memory");
            const unsigned og = xb_add(&bar[XB_TOP], 1u);
            const unsigned tg = og / nx;
            if (og + 1u == (tg + 1u) * nx) xb_add(&bar[XB_TOPGEN], 1u);
            else XB_SPIN(xb_ld(&bar[XB_TOPGEN]) == tg, bar);
            __builtin_amdgcn_fence(__ATOMIC_ACQUIRE, "agent");
            xb_add(&bar[XB_XGEN(b.x)], 1u);
            asm volatile("s_waitcnt vmcnt(0)" ::: "memory");
        } else {
            XB_SPIN(xb_ld(&bar[XB_XGEN(b.x)]) == gen, bar);
            __builtin_amdgcn_fence(__ATOMIC_ACQUIRE, "agent");
            asm volatile("s_waitcnt vmcnt(0)" ::: "memory");
        }
    }
    __syncthreads();
}

__device__ __forceinline__ int srcblk(int mode, int nb) {
    const int pn = nb >> 3, q = nb & 7;
    if (mode == 0) return nb;
    if (mode == 1) return (q >> 2) * 88 + 4 * pn + (q & 3);
    if (mode == 2) return 8 * pn + 2 * (q & 3) + (q >> 2);
    return pn < 8 ? 32 * (1 + (q >> 2)) + 4 * pn + (q & 3) : 8 * (pn - 8) + q;
}
__device__ __forceinline__ void transpose_item(const float* W, int K, int N, bf16_t* WT, int mode, LAS float* scr, int item, int lane) {
    const int nblk = N / 32, kb = item / nblk, nb = item % nblk, k0 = 64 * kb, n0 = 32 * nb, s0 = 32 * srcblk(mode, nb);
    float wv[32];
    const float* wsrc = W + (size_t)(k0 + (lane >> 5)) * N + s0 + (lane & 31);
#pragma unroll
    for (int i = 0; i < 32; ++i) wv[i] = wsrc[(size_t)(2 * i) * N];
#pragma unroll
    for (int i = 0; i < 32; ++i) scr[(2 * i + (lane >> 5)) * 33 + (lane & 31)] = wv[i];
    LDS_WAIT(); asm volatile("" ::: "memory");
    const int c = lane & 7;
#pragma unroll
    for (int j = 0; j < 4; ++j) { const int n = (lane >> 3) + 8 * j; const LAS float* s = scr + (8 * c) * 33 + n;
        u32x4 o; o.x = pk2(s[0 * 33], s[1 * 33]); o.y = pk2(s[2 * 33], s[3 * 33]); o.z = pk2(s[4 * 33], s[5 * 33]); o.w = pk2(s[6 * 33], s[7 * 33]);
        *(u32x4*)(WT + (size_t)(n0 + n) * K + k0 + 8 * c) = o; }
    LDS_WAIT(); asm volatile("" ::: "memory");
}
constexpr int IT_UP = 8 * 2816, IT_DN = 8 * 1408, IT_QKV = 2 * 768, IT_O = 2 * 512, IT_CIN = 2 * 1536, IT_COUT = 2 * 512;
constexpr int NITEMS = IT_UP + IT_DN + IT_QKV + IT_O + IT_CIN + IT_COUT;
__device__ __forceinline__ void conv_item(const Args& a, int it, LAS float* scr, int lane) {
    unsigned char* ws = a.ws; int r = it;
    if (r < IT_UP) { const int i = r / 2816; r -= i * 2816; transpose_item((const float*)a.in[6] + (size_t)i * 1024 * NUP, 1024, NUP, (bf16_t*)(ws + WS_UP) + (size_t)i * NUP * 1024, 1, scr, r, lane); return; }
    r -= IT_UP;
    if (r < IT_DN) { const int i = r / 1408; r -= i * 1408; transpose_item((const float*)a.in[7] + (size_t)i * DFF * 1024, DFF, 1024, (bf16_t*)(ws + WS_DN) + (size_t)i * 1024 * DFF, 0, scr, r, lane); return; }
    r -= IT_DN;
    if (r < IT_QKV) { const int i = r / 768; r -= i * 768; transpose_item((const float*)a.in[8] + (size_t)i * 1024 * NQKV, 1024, NQKV, (bf16_t*)(ws + WS_QKV) + (size_t)i * NQKV * 1024, 2, scr, r, lane); return; }
    r -= IT_QKV;
    if (r < IT_O) { const int i = r / 512; r -= i * 512; transpose_item((const float*)a.in[13] + (size_t)i * 1024 * 1024, 1024, 1024, (bf16_t*)(ws + WS_O) + (size_t)i * 1024 * 1024, 0, scr, r, lane); return; }
    r -= IT_O;
    if (r < IT_CIN) { const int i = r / 1536; r -= i * 1536; transpose_item((const float*)a.in[15] + (size_t)i * 1024 * NCIN, 1024, NCIN, (bf16_t*)(ws + WS_CIN) + (size_t)i * NCIN * 1024, 3, scr, r, lane); return; }
    r -= IT_CIN;
    { const int i = r / 512; r -= i * 512; transpose_item((const float*)a.in[17] + (size_t)i * 1024 * 1024, 1024, 1024, (bf16_t*)(ws + WS_COUT) + (size_t)i * 1024 * 1024, 0, scr, r, lane); }
}

constexpr int GEMV_TASKS = DEPTH * (NADA / 256);
__device__ __forceinline__ void gemv_task(const Args& a, int task, LAS unsigned char* lds, int tid, int lane, int wid) {
    const float* c = (const float*)a.in[1]; const float* w_ada = (const float*)a.in[4]; const float* b_ada = (const float*)a.in[5];
    float* mod = (float*)(a.ws + WS_MOD);
    LAS float* cact = (LAS float*)lds;
    LAS float* red = (LAS float*)(lds + 65536);
    const int l = task / 36, n0 = (task % 36) * 256;
    __syncthreads();
    { int t0 = tid; asm volatile("" : "+v"(t0));
#pragma unroll 4
      for (int i = 0; i < 32; ++i) { const int idx = t0 + 512 * i, k = idx >> 4, b = idx & 15; const float v = c[b * 1024 + k]; cact[idx] = v / (1.f + __expf(-v)); } }
    __syncthreads();
    float acc[64];
#pragma unroll
    for (int i = 0; i < 64; ++i) acc[i] = 0.f;
    const float* wp = w_ada + ((size_t)l * 1024 + wid * 128) * NADA + n0 + 4 * lane;
#pragma unroll 1
    for (int kb = 0; kb < 128; kb += 8) {
        f32x4 wv[8];
#pragma unroll
        for (int u = 0; u < 8; ++u) wv[u] = *(const f32x4*)(wp + (size_t)(kb + u) * NADA);
#pragma unroll
        for (int u = 0; u < 8; ++u) {
            const LAS f32x4* cp = (const LAS f32x4*)(cact + (wid * 128 + kb + u) * 16);
#pragma unroll
            for (int bq = 0; bq < 4; ++bq) { const f32x4 cb = cp[bq];
#pragma unroll
                for (int e = 0; e < 4; ++e)
#pragma unroll
                    for (int j = 0; j < 4; ++j) acc[(bq * 4 + e) * 4 + j] += cb[e] * wv[u][j]; }
            asm volatile("" ::: "memory");
        }
    }
#pragma unroll
    for (int r = 0; r < 2; ++r) {
#pragma unroll
        for (int q = 0; q < 32; ++q) red[(wid * 32 + q) * 64 + lane] = acc[32 * r + q];
        __syncthreads();
#pragma unroll
        for (int i = 0; i < 4; ++i) { const int idx = tid + 512 * i, q = idx >> 6, ln = idx & 63; float s = 0.f;
#pragma unroll
            for (int w = 0; w < 8; ++w) s += red[(w * 32 + q) * 64 + ln];
            const int A = 32 * r + q, bb = A >> 2, j = A & 3;
            mod[((size_t)l * 16 + bb) * NADA + n0 + 4 * ln + j] = s + b_ada[l * NADA + n0 + 4 * ln + j]; }
        __syncthreads();
    }
}

__device__ __forceinline__ void sincos_acc(float angf, float& co, float& si) {
    const double a = (double)angf;
    const double qd = __builtin_rint(a * 0.63661977236758134308);
    const double r = __builtin_fma(-qd, 1.57079632679489661923, a), r2 = r * r;
    double sp = 1.0 / 6227020800.0; sp = sp * r2 - 1.0 / 39916800.0; sp = sp * r2 + 1.0 / 362880.0; sp = sp * r2 - 1.0 / 5040.0; sp = sp * r2 + 1.0 / 120.0; sp = sp * r2 - 1.0 / 6.0; sp = sp * r2 + 1.0; sp = sp * r;
    double cp = 1.0 / 479001600.0; cp = cp * r2 - 1.0 / 3628800.0; cp = cp * r2 + 1.0 / 40320.0; cp = cp * r2 - 1.0 / 720.0; cp = cp * r2 + 1.0 / 24.0; cp = cp * r2 - 0.5; cp = cp * r2 + 1.0;
    const int q = ((int)qd) & 3;
    const double s = (q == 0) ? sp : (q == 1) ? cp : (q == 2) ? -sp : -cp;
    const double cc = (q == 0) ? cp : (q == 1) ? -sp : (q == 2) ? -cp : sp;
    co = (float)cc; si = (float)s;
}

__device__ __forceinline__ void p0a(const Args& a, LAS unsigned char* lds, int tid, int lane, int wid) {
    const int G = gridDim.x, bx = blockIdx.x;
    int ngemv = G < GEMV_TASKS ? G : GEMV_TASKS;
    constexpr int XSPLIT = 3840;
    if (bx < ngemv) { for (int t = bx; t < GEMV_TASKS; t += ngemv) gemv_task(a, t, lds, tid, lane, wid); __syncthreads(); }
    LAS float* scr = (LAS float*)(lds + wid * 16384);
    int xs = 0;
    if (G > ngemv) { xs = XSPLIT; if (bx >= ngemv) { const int nw = (G - ngemv) * NWAVES; for (int it = (bx - ngemv) * NWAVES + wid; it < xs; it += nw) conv_item(a, it, scr, lane); } }
    { const int nw = G * NWAVES; for (int it = xs + bx * NWAVES + wid; it < NITEMS; it += nw) conv_item(a, it, scr, lane); }
    if (bx == 0) { unsigned* bw = (unsigned*)(a.ws + WS_BARW); for (int i = tid; i < XCD_BAR_WORDS; i += NTHREADS) bw[i] = 0u; }
    const int gt = bx * NTHREADS + tid, nt = G * NTHREADS;
    const int* pos = (const int*)a.in[2]; float* cosT = (float*)(a.ws + WS_COS); float* sinT = (float*)(a.ws + WS_SIN);
    for (int idx = gt; idx < MROWS * 32; idx += nt) { const int row = idx >> 5, p = idx & 31; const float ang = (float)pos[row] * INVF[p]; float co, si; sincos_acc(ang, co, si); cosT[idx] = co; sinT[idx] = si; }
}

constexpr int SB_TASKS = (8 * NUP + 2 * NQKV + 2 * NCIN) / 16;
__device__ __forceinline__ void sb_task(const Args& a, int task, int lane) {
    int s = 0, r = task, N = NUP;
    for (s = 0; s < 12; ++s) { const int l = s / 3, j = s % 3; N = (j != 1) ? NUP : ((l & 1) ? NCIN : NQKV); if (r < N / 16) break; r -= N / 16; }
    const int l = s / 3, j = s % 3;
    const bf16_t* Bt;
    if (j == 0) Bt = (const bf16_t*)(a.ws + WS_UP) + (size_t)(2 * l) * NUP * 1024;
    else if (j == 2) Bt = (const bf16_t*)(a.ws + WS_UP) + (size_t)(2 * l + 1) * NUP * 1024;
    else if (l & 1) Bt = (const bf16_t*)(a.ws + WS_CIN) + (size_t)(l >> 1) * NCIN * 1024;
    else Bt = (const bf16_t*)(a.ws + WS_QKV) + (size_t)(l >> 1) * NQKV * 1024;
    const float* shift = (const float*)(a.ws + WS_MOD) + (size_t)l * 16 * NADA + 3 * j * 1024;
    float* sb = (float*)(a.ws + WS_SB) + (size_t)s * SB_STRIDE;
    const int n0 = 16 * r, i16 = lane & 15, kq = lane >> 4;
    const bf16_t* bp = Bt + (size_t)(n0 + i16) * 1024 + 8 * kq;
    const float* sp = shift + (size_t)i16 * NADA + 8 * kq;
    f32x4 c = {0.f, 0.f, 0.f, 0.f};
#pragma unroll 8
    for (int kk = 0; kk < 32; ++kk) {
        const bf16x8 wb = *(const bf16x8*)(bp + 32 * kk);
        const f32x4 s0 = *(const f32x4*)(sp + 32 * kk), s1 = *(const f32x4*)(sp + 32 * kk + 4);
        u32x4 w; w.x = pk2(s0[0], s0[1]); w.y = pk2(s0[2], s0[3]); w.z = pk2(s1[0], s1[1]); w.w = pk2(s1[2], s1[3]);
        c = __builtin_amdgcn_mfma_f32_16x16x32_bf16(wb, __builtin_bit_cast(bf16x8, w), c, 0, 0, 0);
    }
    const int n = n0 + 4 * kq;
    if (j == 1 && !(l & 1)) { const int pn = n >> 8, q = (n >> 5) & 7, src = 256 * pn + 64 * (q & 3) + 32 * (q >> 2) + (n & 31);
        const f32x4 bv = *(const f32x4*)((const float*)a.in[9] + (size_t)(l >> 1) * NQKV + src); c = c + bv; }
    *(f32x4*)(sb + (size_t)i16 * N + n) = c;
}
__device__ __forceinline__ void p0b(const Args& a, int tid, int lane, int wid) {
    const int gw = blockIdx.x * NWAVES + wid, NGW = gridDim.x * NWAVES;
    for (int t = gw; t < SB_TASKS; t += NGW) sb_task(a, t, lane);
    const float* x = (const float*)a.in[0]; const float* gain = (const float*)a.in[3]; const float* mod = (const float*)(a.ws + WS_MOD);
    { float* par = (float*)(a.ws + WS_PAR);
      for (int idx = blockIdx.x * NTHREADS + tid; idx < PAR_N; idx += gridDim.x * NTHREADS) { float v;
          if (idx < PAR_QG) v = ((const float*)a.in[14])[idx]; else if (idx < PAR_KG) v = ((const float*)a.in[10])[idx - PAR_QG]; else if (idx < PAR_SINK) v = ((const float*)a.in[11])[idx - PAR_KG];
          else if (idx < PAR_CW) v = ((const float*)a.in[12])[idx - PAR_SINK]; else v = ((const float*)a.in[16])[idx - PAR_CW];
          par[idx] = v; } }
    { float* GT = (float*)(a.ws + WS_GT); float* GATE = (float*)(a.ws + WS_GATE);
      for (int idx = blockIdx.x * NTHREADS + tid; idx < 12 * 16 * 1024; idx += gridDim.x * NTHREADS) { const int s = idx >> 14, b = (idx >> 10) & 15, k = idx & 1023, l = s / 3, j = s % 3;
          const float* m = mod + ((size_t)l * 16 + b) * NADA + 3 * j * 1024; GT[idx] = gain[s * 1024 + k] * (1.0f + m[1024 + k]); GATE[idx] = (j == 1 ? 1.0f : 0.5f) * m[2048 + k]; } }
    bf16_t* AP = (bf16_t*)(a.ws + WS_AP); float* rs = (float*)(a.ws + WS_RS);
    for (int row0 = gw; row0 < MROWS; row0 += 4 * NGW) {
        f32x4 v[4][4];
#pragma unroll
        for (int q = 0; q < 4; ++q) { const int row = row0 + q * NGW; if (row < MROWS) { const float* xr = x + (size_t)row * 1024 + 4 * lane;
#pragma unroll
                for (int j = 0; j < 4; ++j) v[q][j] = *(const f32x4*)(xr + 256 * j); } }
#pragma unroll
        for (int q = 0; q < 4; ++q) { const int row = row0 + q * NGW; if (row < MROWS) {
            const int b = row >> 11; const float* sc = mod + (size_t)b * NADA + 1024 + 4 * lane; float ss = 0.f;
#pragma unroll
            for (int j = 0; j < 4; ++j) ss += (v[q][j][0] * v[q][j][0] + v[q][j][1] * v[q][j][1]) + (v[q][j][2] * v[q][j][2] + v[q][j][3] * v[q][j][3]);
            ss = wave_sum(ss);
            if (lane < 4) *(f32x4*)(rs + (size_t)row * 16 + 4 * lane) = (f32x4){lane == 0 ? ss : 0.f, 0.f, 0.f, 0.f};
#pragma unroll
            for (int j = 0; j < 4; ++j) { const f32x4 g = *(const f32x4*)(gain + 4 * lane + 256 * j) * (*(const f32x4*)(sc + 256 * j) + 1.0f); const f32x4 o = v[q][j] * g;
                u32x2 w; w.x = pk2(o[0], o[1]); w.y = pk2(o[2], o[3]); *(u32x2*)(AP + (size_t)row * 1024 + 4 * lane + 256 * j) = w; } } }
    }
}

constexpr int ATT_KS = 144, ATT_VS = 260, ATT_VOFF = 256 * ATT_KS;
__device__ __forceinline__ void attn_phase(LAS unsigned char* lds, const bf16_t* Q, const bf16_t* K, const bf16_t* V, bf16_t* O, const float* sinks, int tid, int lane, int wid, int u_first, int u_end, int u_step) {
    const int q32 = lane & 31, hi = lane >> 5;
    const float NEG = -__builtin_inff();
    for (int unit = u_first; unit < u_end; unit += u_step) {
        const int qb = unit & 15, kvh = (unit >> 4) & 3, b = unit >> 6;
        const size_t rowbase = (size_t)b * SEQ; const int kstart = (qb - 1) * 128;
        __syncthreads();
#pragma unroll
        for (int i = 0; i < 4; ++i) { const int idx = tid + 512 * i, row = idx >> 3, ch = idx & 7, kr = kstart + row;
            u32x4 kv = {0u, 0u, 0u, 0u}, vv = {0u, 0u, 0u, 0u};
            if (kr >= 0) { kv = *(const u32x4*)(K + (rowbase + kr) * 256 + kvh * 64 + ch * 8); vv = *(const u32x4*)(V + (rowbase + kr) * 256 + kvh * 64 + ch * 8); }
            *(LAS u32x4*)(lds + row * ATT_KS + ch * 16) = kv;
            LAS bf16_t* vt = (LAS bf16_t*)(lds + ATT_VOFF) + (ch * 8) * ATT_VS + row;
#pragma unroll
            for (int e = 0; e < 8; ++e) vt[e * ATT_VS] = (bf16_t)((vv[e >> 1] >> (16 * (e & 1))) & 0xffffu);
        }
        __syncthreads();
        const int head = kvh * 4 + (wid >> 1), h2 = wid & 1;
        const float sink2 = sinks[head] * 1.44269504f;
#pragma unroll 1
        for (int qi = 0; qi < 2; ++qi) {
            const int qo = 64 * h2 + 32 * qi, kt0 = qo >> 5;
            const size_t qrow = rowbase + qb * 128 + qo + q32;
            bf16x8 qr[4];
#pragma unroll
            for (int ks = 0; ks < 4; ++ks) qr[ks] = *(const bf16x8*)(Q + qrow * 1024 + head * 64 + ks * 16 + hi * 8);
            f32x16 s[5];
#pragma unroll
            for (int j = 0; j < 5; ++j) {
                const int kt = kt0 + j;
                f32x16 acc = {0.f, 0.f, 0.f, 0.f, 0.f, 0.f, 0.f, 0.f, 0.f, 0.f, 0.f, 0.f, 0.f, 0.f, 0.f, 0.f};
#pragma unroll
                for (int ks = 0; ks < 4; ++ks) { const bf16x8 ka = *(const LAS bf16x8*)(lds + (32 * kt + q32) * ATT_KS + ks * 32 + hi * 16);
                    acc = __builtin_amdgcn_mfma_f32_32x32x16_bf16(ka, qr[ks], acc, 0, 0, 0); }
                const bool dead = (qb == 0) && (kt < 4);
#pragma unroll
                for (int r = 0; r < 16; ++r) { const int key = (r & 3) + 8 * (r >> 2) + 4 * hi;
                    bool ok = !dead;
                    if (j == 0) ok = ok && (q32 < key);
                    if (j == 4) ok = ok && (key <= q32);
                    acc[r] = ok ? acc[r] : NEG; }
                s[j] = acc;
            }
            float mx = sink2;
#pragma unroll
            for (int j = 0; j < 5; ++j)
#pragma unroll
                for (int r = 0; r < 16; ++r) mx = fmaxf(mx, s[j][r]);
            mx = fmaxf(mx, __shfl_xor(mx, 32));
            float l = 0.f;
#pragma unroll
            for (int j = 0; j < 5; ++j)
#pragma unroll
                for (int r = 0; r < 16; ++r) { const float p = __builtin_amdgcn_exp2f(s[j][r] - mx); s[j][r] = p; l += p; }
            l += __shfl_xor(l, 32);
            l += __builtin_amdgcn_exp2f(sink2 - mx);
            f32x16 o[2];
#pragma unroll
            for (int db = 0; db < 2; ++db) o[db] = (f32x16){0.f, 0.f, 0.f, 0.f, 0.f, 0.f, 0.f, 0.f, 0.f, 0.f, 0.f, 0.f, 0.f, 0.f, 0.f, 0.f};
#pragma unroll
            for (int j = 0; j < 5; ++j) {
                const int kt = kt0 + j;
#pragma unroll
                for (int st = 0; st < 2; ++st) {
                    u32x4 pw; pw.x = pg8::cvt_pk_bf16(s[j][8 * st + 0], s[j][8 * st + 1]); pw.y = pg8::cvt_pk_bf16(s[j][8 * st + 2], s[j][8 * st + 3]);
                    pw.z = pg8::cvt_pk_bf16(s[j][8 * st + 4], s[j][8 * st + 5]); pw.w = pg8::cvt_pk_bf16(s[j][8 * st + 6], s[j][8 * st + 7]);
                    const bf16x8 pb = __builtin_bit_cast(bf16x8, pw);
#pragma unroll
                    for (int db = 0; db < 2; ++db) {
                        const LAS unsigned char* vp = lds + ATT_VOFF + ((q32 + 32 * db) * ATT_VS + 32 * kt + 16 * st + 4 * hi) * 2;
                        const s16x4 lo = *(const LAS s16x4*)(vp), hh = *(const LAS s16x4*)(vp + 16);
                        const bf16x8 va = {lo[0], lo[1], lo[2], lo[3], hh[0], hh[1], hh[2], hh[3]};
                        o[db] = __builtin_amdgcn_mfma_f32_32x32x16_bf16(va, pb, o[db], 0, 0, 0);
                    }
                }
            }
            const float inv = 1.0f / l;
            bf16_t* op = O + qrow * 1024 + head * 64 + 4 * hi;
#pragma unroll
            for (int db = 0; db < 2; ++db)
#pragma unroll
                for (int rq = 0; rq < 4; ++rq) { u32x2 w; w.x = pg8::cvt_pk_bf16(o[db][4 * rq] * inv, o[db][4 * rq + 1] * inv); w.y = pg8::cvt_pk_bf16(o[db][4 * rq + 2] * inv, o[db][4 * rq + 3] * inv);
                    *(u32x2*)(op + 32 * db + 8 * rq) = w; }
        }
    }
}

__device__ __forceinline__ void unpack8(u32x4 w, float (&f)[8]) {
#pragma unroll
    for (int i = 0; i < 4; ++i) { f[2 * i] = bf_lo(w[i]); f[2 * i + 1] = bf_hi(w[i]); }
}
__device__ __forceinline__ void conv_phase(const bf16_t* U, const bf16_t* GB, bf16_t* A2, const float* cw, int tid, int t_first, int t_end, int t_step) {
    const int c8 = (tid & 127) * 8, chunk = tid >> 7;
    float w0[8], w1[8], w2[8];
#pragma unroll
    for (int e = 0; e < 8; ++e) { w0[e] = cw[c8 + e]; w1[e] = cw[1024 + c8 + e]; w2[e] = cw[2048 + c8 + e]; }
    for (int task = t_first; task < t_end; task += t_step) {
        const int rstart = task * 64 + chunk * 16, t0 = rstart & (SEQ - 1);
        float um2[8], um1[8];
        if (t0 > 0) { unpack8(*(const u32x4*)(U + (size_t)(rstart - 2) * 1024 + c8), um2); unpack8(*(const u32x4*)(U + (size_t)(rstart - 1) * 1024 + c8), um1); }
        else {
#pragma unroll
            for (int e = 0; e < 8; ++e) { um2[e] = 0.f; um1[e] = 0.f; } }
#pragma unroll 4
        for (int i = 0; i < 16; ++i) {
            const size_t off = (size_t)(rstart + i) * 1024 + c8;
            float uc[8], g[8], y[8]; unpack8(*(const u32x4*)(U + off), uc); unpack8(*(const u32x4*)(GB + off), g);
#pragma unroll
            for (int e = 0; e < 8; ++e) { y[e] = g[e] * (w0[e] * um2[e] + w1[e] * um1[e] + w2[e] * uc[e]); um2[e] = um1[e]; um1[e] = uc[e]; }
            u32x4 w; w.x = pk2(y[0], y[1]); w.y = pk2(y[2], y[3]); w.z = pk2(y[4], y[5]); w.w = pk2(y[6], y[7]);
            *(u32x4*)(A2 + off) = w;
        }
    }
}

__device__ __forceinline__ void xcc_barrier(unsigned* bar, unsigned x, unsigned nloc) {
    asm volatile("s_waitcnt vmcnt(0)" ::: "memory");
    __syncthreads();
    if (threadIdx.x == 0) {
        __builtin_amdgcn_s_waitcnt(0);
        const unsigned old = xb_add(&bar[XB_XSUB(x)], 1u);
        const unsigned gen = old / nloc;
        if (old + 1u == (gen + 1u) * nloc) xb_add(&bar[XB_XGEN(x)], 1u);
        else XB_SPIN(xb_ld(&bar[XB_XGEN(x)]) == gen, bar);
        __builtin_amdgcn_fence(__ATOMIC_ACQUIRE, "agent");
        asm volatile("s_waitcnt vmcnt(0)" ::: "memory");
    }
    __syncthreads();
}

__device__ __forceinline__ void grid_seam() {
    asm volatile("s_waitcnt vmcnt(0) lgkmcnt(0)" ::: "memory");
    __syncthreads();
    cg::this_grid().sync();
    __builtin_amdgcn_fence(__ATOMIC_ACQUIRE, "agent");
    asm volatile("s_waitcnt vmcnt(0)" ::: "memory");
}
#ifndef MK_MULTI
#define MK_MULTI 0
#endif
#ifndef LAYER_STEPS
#define LAYER_STEPS {0, 1, 2, 3, 4, 5, 6}
#endif
__device__ const int LSTEP[] = LAYER_STEPS;
constexpr int NLS = sizeof(LSTEP) / sizeof(int);
#ifndef REP_PRO
#define REP_PRO 1
#endif
#ifndef REP_P0B
#define REP_P0B 1
#endif
__global__ void __launch_bounds__(NTHREADS, 2) mk_fwd(Args a) {
    extern __shared__ __attribute__((aligned(16))) unsigned char lds_raw[];
    LAS unsigned char* lds = (LAS unsigned char*)lds_raw;
    unsigned char* ws = a.ws;
    volatile LAS unsigned* bst = (volatile LAS unsigned*)(lds + 131072 + 512);
    if (threadIdx.x == 0) { bst[0] = 0u; bst[1] = 0u; }
    __syncthreads();
    {
        int tid = threadIdx.x; asm volatile("" : "+v"(tid)); const int lane = tid & 63, wid = __builtin_amdgcn_readfirstlane(tid >> 6);
#ifndef NO_P0A
        for (int rep = 0; rep < REP_PRO; ++rep) { p0a(a, lds, tid, lane, wid); __syncthreads(); }
#endif
        grid_seam();
    }
    if (threadIdx.x == 0) bst[2] = xb_add((unsigned*)(ws + WS_BARW) + XB_XCNT(xb_xcc_id()), 1u);
#define XBAR() do { XcdBarrier xb_; xb_.bar = (unsigned*)(ws + WS_BARW); xb_.x = xb_xcc_id(); xb_.st = bst; xcd_barrier(xb_); } while (0)
    {
        int tid = threadIdx.x; asm volatile("" : "+v"(tid)); const int lane = tid & 63, wid = __builtin_amdgcn_readfirstlane(tid >> 6);
#ifndef NO_P0B
        for (int rep = 0; rep < REP_P0B; ++rep) p0b(a, tid, lane, wid);
#endif
        XBAR();
    }
    if (threadIdx.x == 0) { unsigned* bw = (unsigned*)(ws + WS_BARW); bool reg = (gridDim.x == 256u);
        for (unsigned j = 0; j < 8; ++j) reg = reg && (xb_ld(&bw[XB_XCNT(j)]) == 32u);
#ifdef FORCE_GLOBAL
        reg = false;
#endif
        const unsigned x = xb_xcc_id();
        bst[3] = reg ? 1u : 0u; bst[4] = reg ? bst[2] * 8u + x : (unsigned)blockIdx.x; bst[5] = x; }
    __syncthreads();
    const float* xin = (const float*)a.in[0]; float* const outp = a.out;
    for (int it = 0; it < DEPTH * NLS; ++it) {
        unsigned char* ws = a.ws; asm volatile("" : "+s"(ws));
#define SLAB_EL ((size_t)12 * MiB)
#define TBASE(off_el, pitch, flat_el) (BST(3) ? BIG + (size_t)BST(5) * SLAB_EL + (size_t)(off_el) - (size_t)BST(5) * 4096 * (pitch) : BIG + (size_t)(flat_el))
#define T_ACT TBASE(0, DFF, 0)
#define T_Q   TBASE(0, 1024, 0)
#define T_K   TBASE(4 * MiB, 256, 32 * MiB)
#define T_V   TBASE(5 * MiB, 256, 40 * MiB)
#define T_ATT TBASE(6 * MiB, 1024, 48 * MiB)
#define T_U   TBASE(0, 1024, 0)
#define T_GB  TBASE(4 * MiB, 1024, (size_t)MROWS * 1024)
#define T_A2  TBASE(8 * MiB, 1024, (size_t)2 * MROWS * 1024)
#define BST(i) __builtin_amdgcn_readfirstlane((int)bst[i])
        float* rs = (float*)(ws + WS_RS); const float* sbt = (const float*)(ws + WS_SB);
        bf16_t* AP = (bf16_t*)(ws + WS_AP); bf16_t* BIG = (bf16_t*)(ws + WS_BIG);
        const float* GT = (const float*)(ws + WS_GT); const float* GATE = (const float*)(ws + WS_GATE);
        const float* par = (const float*)(ws + WS_PAR);
        int tid = threadIdx.x; asm volatile("" : "+v"(tid));
        const int lane = tid & 63, wid = __builtin_amdgcn_readfirstlane(tid >> 6);
        {
            const int l = it / NLS, k = LSTEP[it % NLS], s0 = 3 * l, jx = l >> 1;
            if (k == 0 || k == 5) {
                const int i = (k == 5), s = s0 + 2 * i;
                pg8::Gemm g{AP, (const bf16_t*)(ws + WS_UP) + (size_t)(2 * l + i) * NUP * 1024, MROWS, NUP, 1024};
                pg8::StaticOrder S; S.init(MROWS, NUP, gridDim.x, BST(4));
                pg8::EpiUp E{T_ACT, rs, sbt + (size_t)s * SB_STRIDE, (LAS float*)(lds + 131072 + 1024), -1};
                #ifndef NO_UP
                pg8::gemm_phase<pg8::EpiUp, pg8::StaticOrder, true, true>(lds, g, S, E, tid);
#endif
            } else if (k == 1 || k == 6 || k == 4) {
                pg8::Gemm g; pg8::EpiResid E;
                const int ridx = 3 * l + (k == 1 ? 0 : (k == 4 ? 1 : 2));
                bf16_t* const xs0 = (bf16_t*)(ws + WS_XALT); bf16_t* const xs1 = xs0 + (size_t)MROWS * 1024;
                E.out_f32 = (ridx == 3 * DEPTH - 1); E.base_f32 = (ridx == 0);
                E.out = E.out_f32 ? (void*)outp : (void*)((ridx & 1) ? xs1 : xs0); E.base = E.base_f32 ? (const void*)xin : (const void*)((ridx & 1) ? xs0 : xs1); E.AP = AP; E.bias = nullptr;
                if (k == 4) {
                    g = pg8::Gemm{(l & 1) ? T_A2 : T_ATT, (l & 1) ? (const bf16_t*)(ws + WS_COUT) + (size_t)jx * 1024 * 1024 : (const bf16_t*)(ws + WS_O) + (size_t)jx * 1024 * 1024, MROWS, 1024, 1024};
                    E.gate = GATE + (s0 + 1) * 16384; if (!(l & 1)) E.bias = par + PAR_BO + jx * 1024;
                    E.Gn = GT + (s0 + 2) * 16384; E.nrowss = rs;
                } else {
                    const int i = (k == 6);
                    g = pg8::Gemm{T_ACT, (const bf16_t*)(ws + WS_DN) + (size_t)(2 * l + i) * 1024 * DFF, MROWS, 1024, DFF};
                    E.gate = GATE + (s0 + 2 * i) * 16384;
                    if (!i) { E.Gn = GT + (s0 + 1) * 16384; E.nrowss = rs; }
                    else if (l < DEPTH - 1) { E.Gn = GT + (s0 + 3) * 16384; E.nrowss = rs; }
                    else { E.AP = nullptr; E.Gn = GT; E.nrowss = rs; }
                }
                pg8::StaticOrder S; S.init(MROWS, 1024, gridDim.x, BST(4));
                #ifndef NO_RES
                pg8::gemm_phase<pg8::EpiResid, pg8::StaticOrder, true, true>(lds, g, S, E, tid);
#endif
            } else if (k == 2) {
                if (!(l & 1)) {
                    pg8::Gemm g{AP, (const bf16_t*)(ws + WS_QKV) + (size_t)jx * NQKV * 1024, MROWS, NQKV, 1024};
                    pg8::StaticOrder S; S.init(MROWS, NQKV, gridDim.x, BST(4));
                    pg8::EpiQKV E{T_Q, T_K, T_V, rs, sbt + (size_t)(s0 + 1) * SB_STRIDE,
                                  par + PAR_QG + jx * 64, par + PAR_KG + jx * 64, (const float*)(ws + WS_COS), (const float*)(ws + WS_SIN)};
                    #ifndef NO_QKV
                    pg8::gemm_phase<pg8::EpiQKV, pg8::StaticOrder, true, true>(lds, g, S, E, tid);
#endif
                } else {
                    pg8::Gemm g{AP, (const bf16_t*)(ws + WS_CIN) + (size_t)jx * NCIN * 1024, MROWS, NCIN, 1024};
                    pg8::StaticOrder S; S.init(MROWS, NCIN, gridDim.x, BST(4));
                    pg8::EpiCin E{T_U, T_GB, rs, sbt + (size_t)(s0 + 1) * SB_STRIDE};
                    #ifndef NO_CIN
                    pg8::gemm_phase<pg8::EpiCin, pg8::StaticOrder, true, true>(lds, g, S, E, tid);
#endif
                }
            } else {
#ifndef NO_ATT
                if (!(l & 1)) attn_phase(lds, T_Q, T_K, T_V, T_ATT, par + PAR_SINK + jx * 16, tid, lane, wid, BST(3) ? BST(5) * 128 + (BST(4) >> 3) : (int)blockIdx.x, BST(3) ? BST(5) * 128 + 128 : NBATCH * 64, BST(3) ? 32 : (int)gridDim.x);
                else
#endif
#ifndef NO_CONV
                conv_phase(T_U, T_GB, T_A2, par + PAR_CW + jx * 3 * 1024, tid, BST(3) ? BST(5) * 64 + (BST(4) >> 3) : (int)blockIdx.x, BST(3) ? BST(5) * 64 + 64 : MROWS / 64, BST(3) ? 32 : (int)gridDim.x);
#endif
                ;
            }
        }
        if (it + 1 < DEPTH * NLS) { unsigned char* ws = a.ws; asm volatile("" : "+s"(ws));
            if (__builtin_amdgcn_readfirstlane((int)bst[3])) xcc_barrier((unsigned*)(ws + WS_BARW), (unsigned)__builtin_amdgcn_readfirstlane((int)bst[5]), 32u); else XBAR();
#ifdef DOUBLE_SEAM
            XBAR(); XBAR();
#endif
        }
    }
}

extern "C" void kernel_launch(void* const* d_in, const int* in_sizes, int n_in, void* d_out, int out_size, void* d_ws, size_t ws_size, hipStream_t stream) {
    static int grid = 0;
    if (grid == 0) {
        if (n_in != 18 || out_size != MROWS * DM || ws_size < WS_END) { fprintf(stderr, "kernel_launch: unexpected problem (n_in %d, out %d, ws %zu); nothing launched\n", n_in, out_size, ws_size); grid = -1; return; }
        int dev = 0, cus = 0, per_cu = 0;
        if (hipGetDevice(&dev) != hipSuccess || hipDeviceGetAttribute(&cus, hipDeviceAttributeMultiprocessorCount, dev) != hipSuccess) { grid = -1; return; }
        if (hipFuncSetAttribute((const void*)mk_fwd, hipFuncAttributeMaxDynamicSharedMemorySize, LDS_BYTES) != hipSuccess) { fprintf(stderr, "kernel_launch: hipFuncSetAttribute failed\n"); grid = -1; return; }
        if (hipOccupancyMaxActiveBlocksPerMultiprocessor(&per_cu, (const void*)mk_fwd, NTHREADS, LDS_BYTES) != hipSuccess || per_cu < 1) { fprintf(stderr, "kernel_launch: occupancy query says %d\n", per_cu); per_cu = 1; }
        (void)hipGetLastError();
        grid = cus * per_cu;
    }
    if (grid < 0) return;
    Args a{};
    for (int i = 0; i < 18; ++i) a.in[i] = d_in[i];
    a.out = (float*)d_out; a.ws = (unsigned char*)d_ws;
#if MK_MULTI
    for (int ph = 0; ph < NPH; ++ph) { a.ph_lo = ph; a.ph_hi = ph + 1; hipLaunchKernelGGL(mk_fwd, dim3(grid), dim3(NTHREADS), LDS_BYTES, stream, a); }
#else
    a.ph_lo = 0; a.ph_hi = NPH;
    void* args[] = {&a};
    hipError_t e = hipLaunchCooperativeKernel((const void*)mk_fwd, dim3(grid), dim3(NTHREADS), args, LDS_BYTES, stream);
    if (e != hipSuccess) fprintf(stderr, "cooperative launch failed: %s (grid %d)\n", hipGetErrorString(e), grid);
#endif
}
```

```cpp
#include <hip/hip_runtime.h>
#include <hip/hip_cooperative_groups.h>
#include <cstdio>
#include <cstdint>
namespace cg = cooperative_groups;
namespace pg8 {
#define PG8_LAS __attribute__((address_space(3)))
typedef unsigned short bf16_t;
typedef short bf16x8 __attribute__((ext_vector_type(8)));
typedef float f32x4 __attribute__((ext_vector_type(4)));
typedef unsigned u32x4 __attribute__((ext_vector_type(4)));
constexpr int BM = 256, BK = 64, HALF = 128, HTB = HALF * BK * 2  , STAGE_BYTES = 8 * HTB, NXCD = 8, WGM = 8;

__host__ __device__ __forceinline__ int lds_byte(int r, int c) { const int st = (r >> 4) * 2 + (c >> 5), rr = r & 15, cc = c & 31, ob = rr * 64 + cc * 2; return st * 1024 + (ob ^ (((ob >> 9) & 1) << 5)); }
__host__ __device__ __forceinline__ void stage_rc(int b, int& R, int& C) { const int st = b / 1024, sb = b % 1024, swz = sb ^ (((sb >> 9) & 1) << 5); R = (st >> 1) * 16 + swz / 64; C = (st & 1) * 32 + (swz % 64) / 2; }
__host__ __device__ __forceinline__ int perm32(int rho) { const int n = rho >> 4, i = rho & 15; return 8 * (i >> 2) + 4 * n + (i & 3); }

struct Unit { int pm, pn; };
struct Gemm { const bf16_t* A; const bf16_t* Bt; int M, N, K; };

struct StaticOrder {
    int nM, nN, nwg, G, c;
    __host__ __device__ void init(int M, int N, int G_, int c_) { nM = M / BM; nN = N / BM; nwg = nM * nN; G = G_; c = c_; }
    __host__ __device__ bool next(int i, Unit& u) const {
        const long L = (long)i * G + c; if (L >= nwg) return false;
        int wgid = (int)L; { const int q = nwg / NXCD, r = nwg % NXCD, xcd = wgid % NXCD, off = wgid / NXCD; wgid = (xcd < r ? xcd * (q + 1) : r * (q + 1) + (xcd - r) * q) + off; }
        const int nig = WGM * nN, gid = wgid / nig, fm = gid * WGM, gsz = (nM - fm) < WGM ? (nM - fm) : WGM;
        u.pm = fm + ((wgid % nig) % gsz); u.pn = (wgid % nig) / gsz; return true;
    }
    __device__ __forceinline__ void a_ready(const Unit&) const {}
    __device__ __forceinline__ void done(const Unit&) const {}
};

typedef float f32x2 __attribute__((ext_vector_type(2)));
typedef __bf16 bf16x2_t __attribute__((ext_vector_type(2)));
__device__ __forceinline__ unsigned cvt_pk_bf16(float lo, float hi) { const f32x2 v = {lo, hi}; const bf16x2_t b = __builtin_convertvector(v, bf16x2_t); return __builtin_bit_cast(unsigned, b); }
typedef unsigned u32x2 __attribute__((ext_vector_type(2)));
#define PG8_GAS __attribute__((address_space(1)))
__device__ __forceinline__ f32x4 ld4(const float* p) { return *(const PG8_GAS f32x4*)p; }
__device__ __forceinline__ u32x4 ld4u(const void* p) { return *(const PG8_GAS u32x4*)p; }
__device__ __forceinline__ void st4f(float* p, f32x4 v) { *(PG8_GAS f32x4*)p = v; }
__device__ __forceinline__ void st4u(void* p, u32x4 v) { *(PG8_GAS u32x4*)p = v; }
__device__ __forceinline__ u32x4 pack8(f32x4 a, f32x4 b) { u32x4 w; w.x = cvt_pk_bf16(a[0], a[1]); w.y = cvt_pk_bf16(a[2], a[3]); w.z = cvt_pk_bf16(b[0], b[1]); w.w = cvt_pk_bf16(b[2], b[3]); return w; }
__device__ __forceinline__ float silu_f(float g) { return g * __builtin_amdgcn_rcpf(1.f + __builtin_amdgcn_exp2f(-1.44269504f * g)); }
__device__ __forceinline__ float rstd_of(float ss, float inv_n) { return 1.0f / sqrtf(ss * inv_n + 1e-6f); }
__device__ __forceinline__ float rstd_row(const float* rsp, int row) {
    const f32x4 a = ld4(rsp + (size_t)row * 16), b = ld4(rsp + (size_t)row * 16 + 4), c = ld4(rsp + (size_t)row * 16 + 8), d = ld4(rsp + (size_t)row * 16 + 12);
    const float s = (((a[0] + a[1]) + (a[2] + a[3])) + ((b[0] + b[1]) + (b[2] + b[3]))) + (((c[0] + c[1]) + (c[2] + c[3])) + ((d[0] + d[1]) + (d[2] + d[3])));
    return rstd_of(s, 1.f / 1024.f);
}

__device__ __forceinline__ void rstd8(const float* rsp, int row0, int fq, float (&r)[2][4]) {
    f32x4 p[2][4];
#pragma unroll
    for (int ai = 0; ai < 2; ++ai)
#pragma unroll
        for (int m = 0; m < 4; ++m) p[ai][m] = ld4(rsp + (size_t)(row0 + ai * 128 + m * 16) * 16 + 4 * fq);
#pragma unroll
    for (int ai = 0; ai < 2; ++ai)
#pragma unroll
        for (int m = 0; m < 4; ++m) { float s = (p[ai][m][0] + p[ai][m][1]) + (p[ai][m][2] + p[ai][m][3]); s += __shfl_xor(s, 16); s += __shfl_xor(s, 32);
            r[ai][m] = __builtin_amdgcn_rsqf(s * (1.f / 1024.f) + 1e-6f); }
}

struct EpiUp {
    static constexpr bool PERM = true, AFTER_DRAIN = false;
    bf16_t* O; const float* rowss; const float* sb; PG8_LAS float* rl; mutable int last_pm;
    __device__ __forceinline__ void operator()(const f32x4 (&acc)[2][2][4][2], const Unit& u, int wr, int wc, int fr, int fq) const {
        const int b = u.pm >> 3;
        const float* sbp = sb + (size_t)b * 5632 + u.pn * 256 + wc * 32 + 8 * fq;
        f32x4 sg[2], su[2];
#pragma unroll
        for (int n = 0; n < 2; ++n) { sg[n] = ld4(sbp + 4 * n); su[n] = ld4(sbp + 128 + 4 * n); }
        const int row0 = u.pm * 256 + wr * 64 + fr;
        bf16_t* ob = O + u.pn * 128 + wc * 32 + 8 * fq;
        float rr[2][4];
        PG8_LAS float* rw = rl + (wr * 4 + wc) * 128 + fr;
        if (u.pm != last_pm) {
            rstd8(rowss, row0, fq, rr);
            if (fq == 0) {
#pragma unroll
                for (int ai = 0; ai < 2; ++ai)
#pragma unroll
                    for (int m = 0; m < 4; ++m) rw[(ai * 4 + m) * 16] = rr[ai][m]; }
            last_pm = u.pm;
        } else {
#pragma unroll
            for (int ai = 0; ai < 2; ++ai)
#pragma unroll
                for (int m = 0; m < 4; ++m) rr[ai][m] = rw[(ai * 4 + m) * 16];
        }
#pragma unroll
        for (int ai = 0; ai < 2; ++ai)
#pragma unroll
            for (int m = 0; m < 4; ++m) {
                const int row = row0 + ai * 128 + m * 16; const float r = rr[ai][m]; const f32x2 r2 = {r, r};
                u32x4 w;
#pragma unroll
                for (int n = 0; n < 2; ++n) { const f32x4 ga = acc[ai][0][m][n], ua = acc[ai][1][m][n];
#pragma unroll
                    for (int h = 0; h < 2; ++h) {
                        const f32x2 g2 = (f32x2){ga[2 * h], ga[2 * h + 1]} * r2 + (f32x2){sg[n][2 * h], sg[n][2 * h + 1]};
                        const f32x2 u2 = (f32x2){ua[2 * h], ua[2 * h + 1]} * r2 + (f32x2){su[n][2 * h], su[n][2 * h + 1]};
                        const f32x2 t2 = g2 * (-1.44269504f);
                        f32x2 d2; d2.x = __builtin_amdgcn_exp2f(t2.x); d2.y = __builtin_amdgcn_exp2f(t2.y); d2 = d2 + 1.0f;
                        f32x2 q2; q2.x = __builtin_amdgcn_rcpf(d2.x); q2.y = __builtin_amdgcn_rcpf(d2.y);
                        const f32x2 a2 = (g2 * u2) * q2;
                        w[2 * n + h] = cvt_pk_bf16(a2.x, a2.y); } }
                st4u(ob + (size_t)row * 2816, w);
            }
    }
};

__device__ __forceinline__ f32x4 bf4_lo(u32x4 w) { f32x4 r; r[0] = __builtin_bit_cast(float, w[0] << 16); r[1] = __builtin_bit_cast(float, w[0] & 0xffff0000u); r[2] = __builtin_bit_cast(float, w[1] << 16); r[3] = __builtin_bit_cast(float, w[1] & 0xffff0000u); return r; }
__device__ __forceinline__ f32x4 bf4_hi(u32x4 w) { f32x4 r; r[0] = __builtin_bit_cast(float, w[2] << 16); r[1] = __builtin_bit_cast(float, w[2] & 0xffff0000u); r[2] = __builtin_bit_cast(float, w[3] << 16); r[3] = __builtin_bit_cast(float, w[3] & 0xffff0000u); return r; }
struct EpiResid {
    static constexpr bool PERM = true, AFTER_DRAIN = false;
    const bf16_t* AP_in; float* out; const float* gate; const float* bias;
    bf16_t* AP; const float* Gn; const float* RGp; float* nrowss;
    __device__ __forceinline__ void operator()(const f32x4 (&acc)[2][2][4][2], const Unit& u, int wr, int wc, int fr, int fq) const {
        const int b = u.pm >> 3;
        const int col0 = u.pn * 256 + wc * 32 + 8 * fq;
        f32x4 gt[2][2], G[2][2], rg[2][2];
#pragma unroll
        for (int bj = 0; bj < 2; ++bj)
#pragma unroll
            for (int n = 0; n < 2; ++n) { const int c = col0 + 128 * bj + 4 * n;
                gt[bj][n] = ld4(gate + b * 1024 + c);
                G[bj][n] = AP ? ld4(Gn + b * 1024 + c) : (f32x4){0.f, 0.f, 0.f, 0.f};
                rg[bj][n] = ld4(RGp + b * 1024 + c); }
        const int row0 = u.pm * 256 + wr * 64 + fr;
#pragma unroll
        for (int ai = 0; ai < 2; ++ai)
#pragma unroll
            for (int m = 0; m < 4; ++m) {
                const int row = row0 + ai * 128 + m * 16; const size_t off = (size_t)row * 1024 + col0; float ss = 0.f;
#pragma unroll
                for (int bj = 0; bj < 2; ++bj) { f32x4 xin[2], xn[2];
                    { const u32x4 w = ld4u(AP_in + off + 128 * bj); xin[0] = bf4_lo(w) * rg[bj][0]; xin[1] = bf4_hi(w) * rg[bj][1]; }
#pragma unroll
                    for (int n = 0; n < 2; ++n) { f32x4 y = acc[ai][bj][m][n]; if (bias) y = y + ld4(bias + col0 + 128 * bj + 4 * n); xn[n] = xin[n] + gt[bj][n] * y;
                        ss += (xn[n][0] * xn[n][0] + xn[n][1] * xn[n][1]) + (xn[n][2] * xn[n][2] + xn[n][3] * xn[n][3]); }
                    if (out) { st4f(out + off + 128 * bj, xn[0]); st4f(out + off + 128 * bj + 4, xn[1]); }
                    if (AP) st4u(AP + off + 128 * bj, pack8(xn[0] * G[bj][0], xn[1] * G[bj][1])); }
                if (AP) { ss += __shfl_xor(ss, 16); ss += __shfl_xor(ss, 32); if (fq == 0) *(PG8_GAS float*)(nrowss + (size_t)row * 16 + u.pn * 4 + wc) = ss; }
                asm volatile("" ::: "memory");
            }
    }
};

struct EpiQKV {
    static constexpr bool PERM = true, AFTER_DRAIN = false;
    bf16_t *Q, *K, *V; const float* rowss; const float* sb; const float* qg; const float* kg; const float* cosT; const float* sinT;
    __device__ __forceinline__ void operator()(const f32x4 (&acc)[2][2][4][2], const Unit& u, int wr, int wc, int fr, int fq) const {
        const int b = u.pm >> 3;
        const float* sbp = sb + (size_t)b * 1536 + u.pn * 256 + wc * 32 + 8 * fq;
        f32x4 sv[2][2], gv[2][2];
        const int typ = u.pn < 4 ? 0 : (u.pn == 4 ? 1 : 2);
        const float* gp = (typ == 0 ? qg : kg) + 8 * fq;
#pragma unroll
        for (int bj = 0; bj < 2; ++bj)
#pragma unroll
            for (int n = 0; n < 2; ++n) { sv[bj][n] = ld4(sbp + 128 * bj + 4 * n); gv[bj][n] = ld4(gp + 32 * bj + 4 * n); }
        const int row0 = u.pm * 256 + wr * 64 + fr;
        float rr[2][4]; rstd8(rowss, row0, fq, rr);
        bf16_t* dst; int pitch; float osc = 1.f;
        if (typ == 0) { dst = Q + (u.pn * 4 + wc) * 64 + 8 * fq; pitch = 1024; osc = 0.125f * 1.44269504f; }
        else if (typ == 1) { dst = K + wc * 64 + 8 * fq; pitch = 256; }
        else { dst = V + wc * 64 + 8 * fq; pitch = 256; }
#pragma unroll
        for (int ai = 0; ai < 2; ++ai)
#pragma unroll
            for (int m = 0; m < 4; ++m) {
                const int row = row0 + ai * 128 + m * 16; const float r = rr[ai][m];
                f32x4 v[2][2]; float ss = 0.f;
#pragma unroll
                for (int bj = 0; bj < 2; ++bj)
#pragma unroll
                    for (int n = 0; n < 2; ++n) { v[bj][n] = acc[ai][bj][m][n] * r + sv[bj][n];
                        ss += (v[bj][n][0] * v[bj][n][0] + v[bj][n][1] * v[bj][n][1]) + (v[bj][n][2] * v[bj][n][2] + v[bj][n][3] * v[bj][n][3]); }
                bf16_t* dp = dst + (size_t)row * pitch;
                if (typ == 2) {
                    st4u(dp, pack8(v[0][0], v[0][1])); st4u(dp + 32, pack8(v[1][0], v[1][1]));
                } else {
                    ss += __shfl_xor(ss, 16); ss += __shfl_xor(ss, 32);
                    const float rn = rstd_of(ss, 1.f / 64.f) * osc;
                    f32x4 o1[2], o2[2];
#pragma unroll
                    for (int n = 0; n < 2; ++n) { const f32x4 cs = ld4(cosT + (size_t)row * 32 + 8 * fq + 4 * n), sn = ld4(sinT + (size_t)row * 32 + 8 * fq + 4 * n);
                        const f32x4 y1 = v[0][n] * gv[0][n] * rn, y2 = v[1][n] * gv[1][n] * rn;
                        o1[n] = y1 * cs - y2 * sn; o2[n] = y2 * cs + y1 * sn; }
                    st4u(dp, pack8(o1[0], o1[1])); st4u(dp + 32, pack8(o2[0], o2[1]));
                }
            }
    }
};

struct EpiCin {
    static constexpr bool PERM = true, AFTER_DRAIN = false;
    bf16_t *U, *GB; const float* rowss; const float* sb;
    __device__ __forceinline__ void operator()(const f32x4 (&acc)[2][2][4][2], const Unit& u, int wr, int wc, int fr, int fq) const {
        const int b = u.pm >> 3;
        const float* sbp = sb + (size_t)b * 3072 + u.pn * 256 + wc * 32 + 8 * fq;
        f32x4 sv[2][2];
#pragma unroll
        for (int bj = 0; bj < 2; ++bj)
#pragma unroll
            for (int n = 0; n < 2; ++n) sv[bj][n] = ld4(sbp + 128 * bj + 4 * n);
        const int row0 = u.pm * 256 + wr * 64 + fr;
        float rr[2][4]; rstd8(rowss, row0, fq, rr);
        const bool isu = u.pn < 8;
        bf16_t* ob = isu ? U + u.pn * 128 + wc * 32 + 8 * fq : GB + (u.pn - 8) * 256 + wc * 32 + 8 * fq;
#pragma unroll
        for (int ai = 0; ai < 2; ++ai)
#pragma unroll
            for (int m = 0; m < 4; ++m) {
                const int row = row0 + ai * 128 + m * 16; const float r = rr[ai][m];
                f32x4 v[2][2];
#pragma unroll
                for (int bj = 0; bj < 2; ++bj)
#pragma unroll
                    for (int n = 0; n < 2; ++n) v[bj][n] = acc[ai][bj][m][n] * r + sv[bj][n];
                bf16_t* dp = ob + (size_t)row * 1024;
                if (isu) { st4u(dp, pack8(v[0][0] * v[1][0], v[0][1] * v[1][1])); }
                else { st4u(dp, pack8(v[0][0], v[0][1])); st4u(dp + 128, pack8(v[1][0], v[1][1])); }
            }
    }
};


struct StaticOrderPF : StaticOrder {
    const float* pbase; PG8_LAS unsigned char* dummy; int ptid;
    __device__ __forceinline__ void a_ready(const Unit& u) const {
#ifdef NO_PF
        return;
#endif
        const char* p = (const char*)pbase + ((size_t)(u.pm * 256) * 1024 + u.pn * 256) * 4;
#pragma unroll
        for (int i = 0; i < 4; ++i) { const int line = ptid + 512 * i;
            __builtin_amdgcn_global_load_lds((const unsigned*)(p + (size_t)(line >> 3) * 4096 + (line & 7) * 128), (PG8_LAS unsigned*)dummy, 4, 0, 0); }
    }
};
template <class Epi, class Sched, bool ALIGN_EPI = false, bool SP2 = false>
__device__ __forceinline__ void gemm_phase(PG8_LAS unsigned char* lds, const Gemm g, const Sched& S, const Epi& E, const int tid_in) {
    const int tid = tid_in, wid = __builtin_amdgcn_readfirstlane(tid >> 6), lane = tid & 63, wr = wid >> 2, wc = wid & 3, fr = lane & 15, fq = lane >> 4;
    const int K = g.K, nt = K / BK;
    unsigned voffA[2], voffB[2];
#pragma unroll
    for (int i = 0; i < 2; ++i) { int R, C; stage_rc(tid * 16 + i * 8192, R, C); const int Rb = Epi::PERM ? ((R & ~31) + perm32(R & 31)) : R;
        voffA[i] = (unsigned)(R * K + C) * 2u; voffB[i] = (unsigned)(Rb * K + C) * 2u; }
    const size_t kstep = (size_t)(BK * 2);
    const size_t hstep = (size_t)HALF * K * 2;
    const size_t tstep = 2 * hstep;
    const unsigned ldsw = (unsigned)wid * 1024u;
    const int aoff = lds_byte(wr * 64 + fr, fq * 8), boff = lds_byte(wc * 32 + fr, fq * 8);
#define PG8_SA(b, h) (((b) * 2 + (h)) * HTB)
#define PG8_SB(b, h) ((4 + (b) * 2 + (h)) * HTB)
#define PG8_STAGE(bufoff, gbase, voff) do { _Pragma("unroll") for (int _i = 0; _i < 2; ++_i) \
        __builtin_amdgcn_global_load_lds((const unsigned*)((const char*)(gbase) + (voff)[_i]), (PG8_LAS unsigned*)(lds + (bufoff) + ldsw + _i * 8192), 16, 0, 0); } while (0)
#define PG8_LDA(dst, b, h) do { _Pragma("unroll") for (int m = 0; m < 4; ++m) _Pragma("unroll") for (int k = 0; k < 2; ++k) dst[m][k] = *(const PG8_LAS bf16x8*)(lds + PG8_SA(b, h) + aoff + m * 2048 + k * 1024); } while (0)
#define PG8_LDB(dst, b, h) do { _Pragma("unroll") for (int n = 0; n < 2; ++n) _Pragma("unroll") for (int k = 0; k < 2; ++k) dst[n][k] = *(const PG8_LAS bf16x8*)(lds + PG8_SB(b, h) + boff + n * 2048 + k * 1024); } while (0)
#define PG8_MMA(ai, bj, At, Bt) do { __builtin_amdgcn_s_setprio(1); _Pragma("unroll") for (int m = 0; m < 4; ++m) _Pragma("unroll") for (int n = 0; n < 2; ++n) _Pragma("unroll") for (int k = 0; k < 2; ++k) \
        acc[ai][bj][m][n] = __builtin_amdgcn_mfma_f32_16x16x32_bf16(Bt[n][k], At[m][k], acc[ai][bj][m][n], 0, 0, 0); __builtin_amdgcn_s_setprio(0); } while (0)
#define PG8_WAIT_V(n) asm volatile("s_waitcnt vmcnt(" #n ")" ::: "memory")
#define PG8_WAIT_L(n) asm volatile("s_waitcnt lgkmcnt(" #n ")" ::: "memory")
#define PG8_BAR __builtin_amdgcn_s_barrier()
#define PG8_SCHED __builtin_amdgcn_sched_barrier(0)
    Unit cur, nxt; int ui = 0;
    if (!S.next(0, cur)) return;
    f32x4 acc[2][2][4][2];
#pragma unroll
    for (int a = 0; a < 2; ++a)
#pragma unroll
        for (int b = 0; b < 2; ++b)
#pragma unroll
            for (int m = 0; m < 4; ++m)
#pragma unroll
                for (int n = 0; n < 2; ++n) acc[a][b][m][n] = (f32x4){0.f, 0.f, 0.f, 0.f};
    bf16x8 At[4][2], B0[2][2], B1[2][2];
    const char* cA = (const char*)g.A + (size_t)cur.pm * tstep; const char* cB = (const char*)g.Bt + (size_t)cur.pn * tstep;
    S.a_ready(cur);
    if constexpr (SP2) {
        PG8_STAGE(PG8_SB(0, 0), cB, voffB); PG8_STAGE(PG8_SB(0, 1), cB + hstep, voffB); PG8_STAGE(PG8_SA(0, 0), cA, voffA); PG8_STAGE(PG8_SA(0, 1), cA + hstep, voffA);
        if (wr == 1) PG8_BAR;
        PG8_WAIT_V(2); PG8_BAR;
        PG8_STAGE(PG8_SB(1, 0), cB + kstep, voffB); PG8_STAGE(PG8_SA(1, 0), cA + kstep, voffA); PG8_STAGE(PG8_SB(1, 1), cB + hstep + kstep, voffB);
        PG8_WAIT_V(6); PG8_BAR;
    } else {
        PG8_STAGE(PG8_SB(0, 0), cB, voffB); PG8_STAGE(PG8_SA(0, 0), cA, voffA); PG8_STAGE(PG8_SB(0, 1), cB + hstep, voffB); PG8_STAGE(PG8_SA(0, 1), cA + hstep, voffA);
        if (wr == 1) PG8_BAR;
        PG8_WAIT_V(4); PG8_BAR;
        PG8_STAGE(PG8_SB(1, 0), cB + kstep, voffB); PG8_STAGE(PG8_SA(1, 0), cA + kstep, voffA); PG8_STAGE(PG8_SB(1, 1), cB + hstep + kstep, voffB);
        PG8_WAIT_V(6); PG8_BAR;
    }
    for (;;) {
        const bool has_next = S.next(ui + 1, nxt);
        const char* nA = has_next ? (const char*)g.A + (size_t)nxt.pm * tstep : cA; const char* nB = has_next ? (const char*)g.Bt + (size_t)nxt.pn * tstep : cB;
        for (int t = 0; t < nt; t += 2) {
            const bool last = (t == nt - 2);
            const char* a1 = cA + (size_t)(t + 1) * kstep;
            const char* a2 = last ? nA : cA + (size_t)(t + 2) * kstep; const char* b2 = last ? nB : cB + (size_t)(t + 2) * kstep;
            const char* a3 = a2 + kstep; const char* b3 = b2 + kstep;
            if (last && has_next) S.a_ready(nxt);
            if constexpr (SP2) {
            PG8_LDB(B0, 0, 0); PG8_LDB(B1, 0, 1); PG8_SCHED; PG8_LDA(At, 0, 0); PG8_STAGE(PG8_SA(1, 1), a1 + hstep, voffA);
            PG8_WAIT_V(8); PG8_WAIT_L(0); PG8_BAR; PG8_MMA(0, 0, At, B0); PG8_MMA(0, 1, At, B1); PG8_BAR; PG8_SCHED;
            PG8_LDA(At, 0, 1); PG8_STAGE(PG8_SB(0, 0), b2, voffB); PG8_STAGE(PG8_SB(0, 1), b2 + hstep, voffB); PG8_STAGE(PG8_SA(0, 0), a2, voffA);
            PG8_WAIT_V(8); PG8_WAIT_L(0); PG8_BAR; PG8_MMA(1, 0, At, B0); PG8_MMA(1, 1, At, B1); PG8_BAR; PG8_SCHED;
            PG8_LDB(B0, 1, 0); PG8_LDB(B1, 1, 1); PG8_SCHED; PG8_LDA(At, 1, 0); PG8_STAGE(PG8_SA(0, 1), a2 + hstep, voffA);
            PG8_WAIT_V(8); PG8_WAIT_L(0); PG8_BAR; PG8_MMA(0, 0, At, B0); PG8_MMA(0, 1, At, B1); PG8_BAR; PG8_SCHED;
            PG8_LDA(At, 1, 1); PG8_STAGE(PG8_SB(1, 0), b3, voffB); PG8_STAGE(PG8_SB(1, 1), b3 + hstep, voffB); PG8_STAGE(PG8_SA(1, 0), a3, voffA);
            PG8_WAIT_V(8); PG8_WAIT_L(0); PG8_BAR; PG8_MMA(1, 0, At, B0); PG8_MMA(1, 1, At, B1); PG8_BAR; PG8_SCHED;
            } else {
            PG8_LDB(B0, 0, 0); PG8_SCHED; PG8_LDA(At, 0, 0); PG8_STAGE(PG8_SA(1, 1), a1 + hstep, voffA);
            PG8_WAIT_L(8); PG8_BAR; PG8_WAIT_L(0); PG8_MMA(0, 0, At, B0); PG8_BAR; PG8_SCHED;
            PG8_LDB(B1, 0, 1); PG8_STAGE(PG8_SB(0, 0), b2, voffB);
            PG8_BAR; PG8_WAIT_L(0); PG8_MMA(0, 1, At, B1); PG8_BAR;
            PG8_LDA(At, 0, 1); PG8_STAGE(PG8_SA(0, 0), a2, voffA);
            PG8_BAR; PG8_WAIT_L(0); PG8_MMA(1, 0, At, B0); PG8_BAR; PG8_SCHED;
            PG8_STAGE(PG8_SB(0, 1), b2 + hstep, voffB);
            PG8_WAIT_V(6); PG8_BAR; PG8_MMA(1, 1, At, B1); PG8_BAR;
            PG8_LDB(B0, 1, 0); PG8_SCHED; PG8_LDA(At, 1, 0); PG8_STAGE(PG8_SA(0, 1), a2 + hstep, voffA);
            PG8_WAIT_L(8); PG8_BAR; PG8_WAIT_L(0); PG8_MMA(0, 0, At, B0); PG8_BAR; PG8_SCHED;
            PG8_LDB(B1, 1, 1); PG8_STAGE(PG8_SB(1, 0), b3, voffB);
            PG8_BAR; PG8_WAIT_L(0); PG8_MMA(0, 1, At, B1); PG8_BAR;
            PG8_LDA(At, 1, 1); PG8_STAGE(PG8_SA(1, 0), a3, voffA);
            PG8_BAR; PG8_WAIT_L(0); PG8_MMA(1, 0, At, B0); PG8_BAR; PG8_SCHED;
            PG8_STAGE(PG8_SB(1, 1), b3 + hstep, voffB);
            PG8_WAIT_V(6); PG8_BAR; PG8_MMA(1, 1, At, B1); PG8_BAR;
            }
        }
        if constexpr (ALIGN_EPI) { if (wr == 0) PG8_BAR; }
        if constexpr (!Epi::AFTER_DRAIN) { E(acc, cur, wr, wc, fr, fq); S.done(cur); }
        if (!has_next) break;
#pragma unroll
        for (int a = 0; a < 2; ++a)
#pragma unroll
            for (int b = 0; b < 2; ++b)
#pragma unroll
                for (int m = 0; m < 4; ++m)
#pragma unroll
                    for (int n = 0; n < 2; ++n) acc[a][b][m][n] = (f32x4){0.f, 0.f, 0.f, 0.f};
        cur = nxt; cA = nA; cB = nB; ++ui;
        if constexpr (ALIGN_EPI) { if (wr == 1) PG8_BAR; }
    }
    PG8_WAIT_V(0);
    if constexpr (!ALIGN_EPI) { if (wr == 0) PG8_BAR; }
    PG8_BAR;
    if constexpr (Epi::AFTER_DRAIN) { E.fused(acc, cur, wr, wc, fr, fq, lds, wid, lane); S.done(cur); }
#undef PG8_SA
#undef PG8_SB
#undef PG8_STAGE
#undef PG8_LDA
#undef PG8_LDB
#undef PG8_MMA
#undef PG8_WAIT_V
#undef PG8_WAIT_L
#undef PG8_BAR
#undef PG8_SCHED
}
}

#define LAS __attribute__((address_space(3)))
typedef pg8::bf16_t bf16_t;
typedef short bf16x8 __attribute__((ext_vector_type(8)));
typedef short s16x4 __attribute__((ext_vector_type(4)));
typedef float f32x4 __attribute__((ext_vector_type(4)));
typedef float f32x16 __attribute__((ext_vector_type(16)));
typedef unsigned u32x4 __attribute__((ext_vector_type(4)));
typedef unsigned u32x2 __attribute__((ext_vector_type(2)));

constexpr int DM = 1024, NBATCH = 16, SEQ = 2048, MROWS = NBATCH * SEQ, DFF = 2816, NUP = 2 * DFF, NQKV = 1536, NCIN = 3072, NADA = 9 * DM, DEPTH = 4;
constexpr int NWAVES = 8, NTHREADS = NWAVES * 64;
constexpr int LDS_BYTES = 131072 + 1024 + 4096;
constexpr size_t MiB = 1u << 20;
constexpr size_t WS_UP = 0, WS_DN = 88 * MiB, WS_QKV = 132 * MiB, WS_O = 138 * MiB, WS_CIN = 142 * MiB, WS_COUT = 154 * MiB;
constexpr size_t WS_MOD = 158 * MiB, WS_SB = 161 * MiB, WS_RS = 166 * MiB, WS_COS = 168 * MiB, WS_SIN = 172 * MiB, WS_GT = 176 * MiB, WS_GATE = 177 * MiB, WS_AP = 178 * MiB, WS_BIG = 242 * MiB, WS_XALT = 434 * MiB, WS_END = 562 * MiB;
constexpr size_t WS_PAR = 177 * MiB + 768 * 1024;
constexpr int PAR_BO = 0, PAR_QG = 2048, PAR_KG = 2176, PAR_SINK = 2304, PAR_CW = 2336, PAR_N = 2336 + 6144;
constexpr size_t WS_BARW = WS_PAR + 64 * 1024;
constexpr size_t SB_STRIDE = (size_t)16 * NUP;
constexpr int NPH = 2 + 7 * DEPTH;

struct Args { const void* in[18]; float* out; unsigned char* ws; int ph_lo, ph_hi; };

__device__ const float INVF[32] = {1.0f, 0.7498942613601685f, 0.5623413324356079f, 0.4216965138912201f, 0.3162277638912201f, 0.23713737726211548f, 0.17782793939113617f, 0.133352130651474f,
    0.10000000149011612f, 0.07498941570520401f, 0.05623413249850273f, 0.04216965287923813f, 0.03162277489900589f, 0.023713737726211548f, 0.017782794311642647f, 0.01333521492779255f,
    0.009999999776482582f, 0.007498941849917173f, 0.005623413249850273f, 0.0042169648222625256f, 0.003162277629598975f, 0.00237137358635664f, 0.0017782794311642647f, 0.0013335214462131262f,
    0.0010000000474974513f, 0.0007498942431993783f, 0.000562341301701963f, 0.0004216965171508491f, 0.0003162277571391314f, 0.00023713737027719617f, 0.00017782794020604342f, 0.0001333521504420787f};

#define LDS_WAIT() asm volatile("s_waitcnt lgkmcnt(0)" ::: "memory")
__device__ __forceinline__ unsigned f2bf(float f) { unsigned u = __builtin_bit_cast(unsigned, f); return (u + 0x7fffu + ((u >> 16) & 1u)) >> 16; }
__device__ __forceinline__ unsigned pk2(float lo, float hi) { return f2bf(lo) | (f2bf(hi) << 16); }
__device__ __forceinline__ float bf_lo(unsigned w) { return __builtin_bit_cast(float, w << 16); }
__device__ __forceinline__ float bf_hi(unsigned w) { return __builtin_bit_cast(float, w & 0xffff0000u); }
__device__ __forceinline__ float wave_sum(float v) {
#pragma unroll
    for (int o = 1; o < 64; o <<= 1) v += __shfl_xor(v, o);
    return v;
}

#define RLX_AGENT __ATOMIC_RELAXED, __HIP_MEMORY_SCOPE_AGENT
#define XB_TMO      128
#define XB_XCNT(j)  (256  + 64 * (j))
#define XB_XSUB(j)  (1280 + 64 * (j))
#define XB_XGEN(j)  (2304 + 64 * (j))
#define XB_TOP      3328
#define XB_TOPGEN   3392
#define XCD_BAR_WORDS 3456
#define XB_SPIN_CAP (1u << 18)

__device__ __forceinline__ unsigned xb_ld(unsigned* p)              { return __hip_atomic_load(p, __ATOMIC_RELAXED, __HIP_MEMORY_SCOPE_AGENT); }
__device__ __forceinline__ unsigned xb_add(unsigned* p, unsigned v) { return __hip_atomic_fetch_add(p, v, __ATOMIC_RELAXED, __HIP_MEMORY_SCOPE_AGENT); }
__device__ __forceinline__ unsigned xb_xcc_id() { return (unsigned)__builtin_amdgcn_s_getreg((3 << 11) | 20) & 0xFu; }
#define XB_SPIN(cond, bar) do { unsigned _sp = 0; while (cond) { __builtin_amdgcn_s_sleep(1); \
    if ((++_sp & 255u) == 0u) { if (xb_ld(&(bar)[XB_TMO])) break; if (_sp > XB_SPIN_CAP) { atomicAdd(&(bar)[XB_TMO], 1u); break; } } } } while (0)

struct XcdBarrier {
    unsigned* bar; unsigned x;
    volatile LAS unsigned* st;
};

__device__ __forceinline__ XcdBarrier xcd_barrier_post(unsigned* bar, volatile LAS unsigned* st) {
    XcdBarrier b; b.bar = bar; b.x = xb_xcc_id(); b.st = st;
    if (threadIdx.x == 0) (void)xb_add(&bar[XB_XCNT(b.x)], 1u);
    return b;
}
__device__ __forceinline__ void xcd_barrier_complete(unsigned* bar, unsigned x, unsigned& nloc, unsigned& nx) {
    const unsigned G = gridDim.x * gridDim.y * gridDim.z;
    unsigned sum, cnt, mine, sp = 0u;
    for (;;) {
        sum = 0u; cnt = 0u; mine = 0u;
#pragma unroll
        for (unsigned j = 0; j < 16; ++j) { const unsigned c = xb_ld(&bar[XB_XCNT(j)]); sum += c; cnt += (c > 0u) ? 1u : 0u; mine = (j == x) ? c : mine; }
        if (sum == G) break;
        __builtin_amdgcn_s_sleep(1);
        if ((++sp & 255u) == 0u) { if (xb_ld(&bar[XB_TMO])) break; if (sp > XB_SPIN_CAP) { atomicAdd(&bar[XB_TMO], 1u); break; } }
    }
    nloc = mine > 0u ? mine : 1u; nx = cnt > 0u ? cnt : 1u;
}

__device__ __forceinline__ void xcd_barrier(const XcdBarrier& b) {
    asm volatile("s_waitcnt vmcnt(0)" ::: "memory");
    __syncthreads();
    if (threadIdx.x == 0) {
        unsigned* bar = b.bar;
        __builtin_amdgcn_s_waitcnt(0);
        unsigned nloc = b.st[0], nx = b.st[1];
        if (nloc == 0u) { xcd_barrier_complete(bar, b.x, nloc, nx); b.st[0] = nloc; b.st[1] = nx; }
        const unsigned old = xb_add(&bar[XB_XSUB(b.x)], 1u);
        const unsigned gen = old / nloc;
        if (old + 1u == (gen + 1u) * nloc) {
            __builtin_amdgcn_fence(__ATOMIC_RELEASE, "agent");
            asm volatile("s_waitcnt vmcnt(0)" ::: "memory");
            const unsigned og = xb_add(&bar[XB_TOP], 1u);
            const unsigned tg = og / nx;
            if (og + 1u == (tg + 1u) * nx) xb_add(&bar[XB_TOPGEN], 1u);
            else XB_SPIN(xb_ld(&bar[XB_TOPGEN]) == tg, bar);
            __builtin_amdgcn_fence(__ATOMIC_ACQUIRE, "agent");
            xb_add(&bar[XB_XGEN(b.x)], 1u);
            asm volatile("s_waitcnt vmcnt(0)" ::: "memory");
        } else {
            XB_SPIN(xb_ld(&bar[XB_XGEN(b.x)]) == gen, bar);
            __builtin_amdgcn_fence(__ATOMIC_ACQUIRE, "agent");
            asm volatile("s_waitcnt vmcnt(0)" ::: "memory");
        }
    }
    __syncthreads();
}

__device__ __forceinline__ int srcblk(int mode, int nb) {
    const int pn = nb >> 3, q = nb & 7;
    if (mode == 0) return nb;
    if (mode == 1) return (q >> 2) * 88 + 4 * pn + (q & 3);
    if (mode == 2) return 8 * pn + 2 * (q & 3) + (q >> 2);
    return pn < 8 ? 32 * (1 + (q >> 2)) + 4 * pn + (q & 3) : 8 * (pn - 8) + q;
}
__device__ __forceinline__ void transpose_item(const float* W, int K, int N, bf16_t* WT, int mode, LAS float* scr, int item, int lane) {
    const int nblk = N / 32, kb = item / nblk, nb = item % nblk, k0 = 64 * kb, n0 = 32 * nb, s0 = 32 * srcblk(mode, nb);
    float wv[32];
    const float* wsrc = W + (size_t)(k0 + (lane >> 5)) * N + s0 + (lane & 31);
#pragma unroll
    for (int i = 0; i < 32; ++i) wv[i] = wsrc[(size_t)(2 * i) * N];
#pragma unroll
    for (int i = 0; i < 32; ++i) scr[(2 * i + (lane >> 5)) * 33 + (lane & 31)] = wv[i];
    LDS_WAIT(); asm volatile("" ::: "memory");
    const int c = lane & 7;
#pragma unroll
    for (int j = 0; j < 4; ++j) { const int n = (lane >> 3) + 8 * j; const LAS float* s = scr + (8 * c) * 33 + n;
        u32x4 o; o.x = pk2(s[0 * 33], s[1 * 33]); o.y = pk2(s[2 * 33], s[3 * 33]); o.z = pk2(s[4 * 33], s[5 * 33]); o.w = pk2(s[6 * 33], s[7 * 33]);
        *(u32x4*)(WT + (size_t)(n0 + n) * K + k0 + 8 * c) = o; }
    LDS_WAIT(); asm volatile("" ::: "memory");
}
constexpr int IT_UP = 8 * 2816, IT_DN = 8 * 1408, IT_QKV = 2 * 768, IT_O = 2 * 512, IT_CIN = 2 * 1536, IT_COUT = 2 * 512;
constexpr int NITEMS = IT_UP + IT_DN + IT_QKV + IT_O + IT_CIN + IT_COUT;
__device__ __forceinline__ void conv_item(const Args& a, int it, LAS float* scr, int lane) {
    unsigned char* ws = a.ws; int r = it;
    if (r < IT_UP) { const int i = r / 2816; r -= i * 2816; transpose_item((const float*)a.in[6] + (size_t)i * 1024 * NUP, 1024, NUP, (bf16_t*)(ws + WS_UP) + (size_t)i * NUP * 1024, 1, scr, r, lane); return; }
    r -= IT_UP;
    if (r < IT_DN) { const int i = r / 1408; r -= i * 1408; transpose_item((const float*)a.in[7] + (size_t)i * DFF * 1024, DFF, 1024, (bf16_t*)(ws + WS_DN) + (size_t)i * 1024 * DFF, 0, scr, r, lane); return; }
    r -= IT_DN;
    if (r < IT_QKV) { const int i = r / 768; r -= i * 768; transpose_item((const float*)a.in[8] + (size_t)i * 1024 * NQKV, 1024, NQKV, (bf16_t*)(ws + WS_QKV) + (size_t)i * NQKV * 1024, 2, scr, r, lane); return; }
    r -= IT_QKV;
    if (r < IT_O) { const int i = r / 512; r -= i * 512; transpose_item((const float*)a.in[13] + (size_t)i * 1024 * 1024, 1024, 1024, (bf16_t*)(ws + WS_O) + (size_t)i * 1024 * 1024, 0, scr, r, lane); return; }
    r -= IT_O;
    if (r < IT_CIN) { const int i = r / 1536; r -= i * 1536; transpose_item((const float*)a.in[15] + (size_t)i * 1024 * NCIN, 1024, NCIN, (bf16_t*)(ws + WS_CIN) + (size_t)i * NCIN * 1024, 3, scr, r, lane); return; }
    r -= IT_CIN;
    { const int i = r / 512; r -= i * 512; transpose_item((const float*)a.in[17] + (size_t)i * 1024 * 1024, 1024, 1024, (bf16_t*)(ws + WS_COUT) + (size_t)i * 1024 * 1024, 0, scr, r, lane); }
}

constexpr int GEMV_TASKS = DEPTH * (NADA / 256);
__device__ __forceinline__ void gemv_task(const Args& a, int task, LAS unsigned char* lds, int tid, int lane, int wid) {
    const float* c = (const float*)a.in[1]; const float* w_ada = (const float*)a.in[4]; const float* b_ada = (const float*)a.in[5];
    float* mod = (float*)(a.ws + WS_MOD);
    LAS float* cact = (LAS float*)lds;
    LAS float* red = (LAS float*)(lds + 65536);
    const int l = task / 36, n0 = (task % 36) * 256;
    __syncthreads();
    { int t0 = tid; asm volatile("" : "+v"(t0));
#pragma unroll 4
      for (int i = 0; i < 32; ++i) { const int idx = t0 + 512 * i, k = idx >> 4, b = idx & 15; const float v = c[b * 1024 + k]; cact[idx] = v / (1.f + __expf(-v)); } }
    __syncthreads();
    float acc[64];
#pragma unroll
    for (int i = 0; i < 64; ++i) acc[i] = 0.f;
    const float* wp = w_ada + ((size_t)l * 1024 + wid * 128) * NADA + n0 + 4 * lane;
#pragma unroll 1
    for (int kb = 0; kb < 128; kb += 8) {
        f32x4 wv[8];
#pragma unroll
        for (int u = 0; u < 8; ++u) wv[u] = *(const f32x4*)(wp + (size_t)(kb + u) * NADA);
#pragma unroll
        for (int u = 0; u < 8; ++u) {
            const LAS f32x4* cp = (const LAS f32x4*)(cact + (wid * 128 + kb + u) * 16);
#pragma unroll
            for (int bq = 0; bq < 4; ++bq) { const f32x4 cb = cp[bq];
#pragma unroll
                for (int e = 0; e < 4; ++e)
#pragma unroll
                    for (int j = 0; j < 4; ++j) acc[(bq * 4 + e) * 4 + j] += cb[e] * wv[u][j]; }
            asm volatile("" ::: "memory");
        }
    }
#pragma unroll
    for (int r = 0; r < 2; ++r) {
#pragma unroll
        for (int q = 0; q < 32; ++q) red[(wid * 32 + q) * 64 + lane] = acc[32 * r + q];
        __syncthreads();
#pragma unroll
        for (int i = 0; i < 4; ++i) { const int idx = tid + 512 * i, q = idx >> 6, ln = idx & 63; float s = 0.f;
#pragma unroll
            for (int w = 0; w < 8; ++w) s += red[(w * 32 + q) * 64 + ln];
            const int A = 32 * r + q, bb = A >> 2, j = A & 3;
            mod[((size_t)l * 16 + bb) * NADA + n0 + 4 * ln + j] = s + b_ada[l * NADA + n0 + 4 * ln + j]; }
        __syncthreads();
    }
}

__device__ __forceinline__ void sincos_acc(float angf, float& co, float& si) {
    const double a = (double)angf;
    const double qd = __builtin_rint(a * 0.63661977236758134308);
    const double r = __builtin_fma(-qd, 1.57079632679489661923, a), r2 = r * r;
    double sp = 1.0 / 6227020800.0; sp = sp * r2 - 1.0 / 39916800.0; sp = sp * r2 + 1.0 / 362880.0; sp = sp * r2 - 1.0 / 5040.0; sp = sp * r2 + 1.0 / 120.0; sp = sp * r2 - 1.0 / 6.0; sp = sp * r2 + 1.0; sp = sp * r;
    double cp = 1.0 / 479001600.0; cp = cp * r2 - 1.0 / 3628800.0; cp = cp * r2 + 1.0 / 40320.0; cp = cp * r2 - 1.0 / 720.0; cp = cp * r2 + 1.0 / 24.0; cp = cp * r2 - 0.5; cp = cp * r2 + 1.0;
    const int q = ((int)qd) & 3;
    const double s = (q == 0) ? sp : (q == 1) ? cp : (q == 2) ? -sp : -cp;
    const double cc = (q == 0) ? cp : (q == 1) ? -sp : (q == 2) ? -cp : sp;
    co = (float)cc; si = (float)s;
}

__device__ __forceinline__ void p0a(const Args& a, LAS unsigned char* lds, int tid, int lane, int wid) {
    const int G = gridDim.x, bx = blockIdx.x;
    int ngemv = G < GEMV_TASKS ? G : GEMV_TASKS;
    constexpr int XSPLIT = 3840;
    if (bx < ngemv) { for (int t = bx; t < GEMV_TASKS; t += ngemv) gemv_task(a, t, lds, tid, lane, wid); __syncthreads(); }
    LAS float* scr = (LAS float*)(lds + wid * 16384);
    int xs = 0;
    if (G > ngemv) { xs = XSPLIT; if (bx >= ngemv) { const int nw = (G - ngemv) * NWAVES; for (int it = (bx - ngemv) * NWAVES + wid; it < xs; it += nw) conv_item(a, it, scr, lane); } }
    { const int nw = G * NWAVES; for (int it = xs + bx * NWAVES + wid; it < NITEMS; it += nw) conv_item(a, it, scr, lane); }
    if (bx == 0) { unsigned* bw = (unsigned*)(a.ws + WS_BARW); for (int i = tid; i < XCD_BAR_WORDS; i += NTHREADS) bw[i] = 0u; }
    const int gt = bx * NTHREADS + tid, nt = G * NTHREADS;
    const int* pos = (const int*)a.in[2]; float* cosT = (float*)(a.ws + WS_COS); float* sinT = (float*)(a.ws + WS_SIN);
    for (int idx = gt; idx < MROWS * 32; idx += nt) { const int row = idx >> 5, p = idx & 31; const float ang = (float)pos[row] * INVF[p]; float co, si; sincos_acc(ang, co, si); cosT[idx] = co; sinT[idx] = si; }
}

__device__ __forceinline__ float gclamp(float g) { return fabsf(g) < 1e-20f ? copysignf(1e-20f, g) : g; }
constexpr int SB_TASKS = (8 * NUP + 2 * NQKV + 2 * NCIN) / 16;
__device__ __forceinline__ void sb_task(const Args& a, int task, int lane) {
    int s = 0, r = task, N = NUP;
    for (s = 0; s < 12; ++s) { const int l = s / 3, j = s % 3; N = (j != 1) ? NUP : ((l & 1) ? NCIN : NQKV); if (r < N / 16) break; r -= N / 16; }
    const int l = s / 3, j = s % 3;
    const bf16_t* Bt;
    if (j == 0) Bt = (const bf16_t*)(a.ws + WS_UP) + (size_t)(2 * l) * NUP * 1024;
    else if (j == 2) Bt = (const bf16_t*)(a.ws + WS_UP) + (size_t)(2 * l + 1) * NUP * 1024;
    else if (l & 1) Bt = (const bf16_t*)(a.ws + WS_CIN) + (size_t)(l >> 1) * NCIN * 1024;
    else Bt = (const bf16_t*)(a.ws + WS_QKV) + (size_t)(l >> 1) * NQKV * 1024;
    const float* shift = (const float*)(a.ws + WS_MOD) + (size_t)l * 16 * NADA + 3 * j * 1024;
    float* sb = (float*)(a.ws + WS_SB) + (size_t)s * SB_STRIDE;
    const int n0 = 16 * r, i16 = lane & 15, kq = lane >> 4;
    const bf16_t* bp = Bt + (size_t)(n0 + i16) * 1024 + 8 * kq;
    const float* sp = shift + (size_t)i16 * NADA + 8 * kq;
    f32x4 c = {0.f, 0.f, 0.f, 0.f};
#pragma unroll 8
    for (int kk = 0; kk < 32; ++kk) {
        const bf16x8 wb = *(const bf16x8*)(bp + 32 * kk);
        const f32x4 s0 = *(const f32x4*)(sp + 32 * kk), s1 = *(const f32x4*)(sp + 32 * kk + 4);
        u32x4 w; w.x = pk2(s0[0], s0[1]); w.y = pk2(s0[2], s0[3]); w.z = pk2(s1[0], s1[1]); w.w = pk2(s1[2], s1[3]);
        c = __builtin_amdgcn_mfma_f32_16x16x32_bf16(wb, __builtin_bit_cast(bf16x8, w), c, 0, 0, 0);
    }
    const int n = n0 + 4 * kq;
    if (j == 1 && !(l & 1)) { const int pn = n >> 8, q = (n >> 5) & 7, src = 256 * pn + 64 * (q & 3) + 32 * (q >> 2) + (n & 31);
        const f32x4 bv = *(const f32x4*)((const float*)a.in[9] + (size_t)(l >> 1) * NQKV + src); c = c + bv; }
    *(f32x4*)(sb + (size_t)i16 * N + n) = c;
}
__device__ __forceinline__ void p0b(const Args& a, int tid, int lane, int wid) {
    const int gw = blockIdx.x * NWAVES + wid, NGW = gridDim.x * NWAVES;
    for (int t = gw; t < SB_TASKS; t += NGW) sb_task(a, t, lane);
    const float* x = (const float*)a.in[0]; const float* gain = (const float*)a.in[3]; const float* mod = (const float*)(a.ws + WS_MOD);
    { float* par = (float*)(a.ws + WS_PAR);
      for (int idx = blockIdx.x * NTHREADS + tid; idx < PAR_N; idx += gridDim.x * NTHREADS) { float v;
          if (idx < PAR_QG) v = ((const float*)a.in[14])[idx]; else if (idx < PAR_KG) v = ((const float*)a.in[10])[idx - PAR_QG]; else if (idx < PAR_SINK) v = ((const float*)a.in[11])[idx - PAR_KG];
          else if (idx < PAR_CW) v = ((const float*)a.in[12])[idx - PAR_SINK]; else v = ((const float*)a.in[16])[idx - PAR_CW];
          par[idx] = v; } }
    { float* GT = (float*)(a.ws + WS_GT); float* GATE = (float*)(a.ws + WS_GATE);
      for (int idx = blockIdx.x * NTHREADS + tid; idx < 12 * 16 * 1024; idx += gridDim.x * NTHREADS) { const int s = idx >> 14, b = (idx >> 10) & 15, k = idx & 1023, l = s / 3, j = s % 3;
          const float* m = mod + ((size_t)l * 16 + b) * NADA + 3 * j * 1024; { const float g_ = gclamp(gain[s * 1024 + k] * (1.0f + m[1024 + k])); GT[idx] = g_; ((float*)(a.ws + WS_XALT))[idx] = 1.0f / g_; } GATE[idx] = (j == 1 ? 1.0f : 0.5f) * m[2048 + k]; } }
    bf16_t* AP = (bf16_t*)(a.ws + WS_AP); float* rs = (float*)(a.ws + WS_RS);
    for (int row0 = gw; row0 < MROWS; row0 += 4 * NGW) {
        f32x4 v[4][4];
#pragma unroll
        for (int q = 0; q < 4; ++q) { const int row = row0 + q * NGW; if (row < MROWS) { const float* xr = x + (size_t)row * 1024 + 4 * lane;
#pragma unroll
                for (int j = 0; j < 4; ++j) v[q][j] = *(const f32x4*)(xr + 256 * j); } }
#pragma unroll
        for (int q = 0; q < 4; ++q) { const int row = row0 + q * NGW; if (row < MROWS) {
            const int b = row >> 11; const float* sc = mod + (size_t)b * NADA + 1024 + 4 * lane; float ss = 0.f;
#pragma unroll
            for (int j = 0; j < 4; ++j) ss += (v[q][j][0] * v[q][j][0] + v[q][j][1] * v[q][j][1]) + (v[q][j][2] * v[q][j][2] + v[q][j][3] * v[q][j][3]);
            ss = wave_sum(ss);
            if (lane < 4) *(f32x4*)(rs + (size_t)row * 16 + 4 * lane) = (f32x4){lane == 0 ? ss : 0.f, 0.f, 0.f, 0.f};
#pragma unroll
            for (int j = 0; j < 4; ++j) { f32x4 g = *(const f32x4*)(gain + 4 * lane + 256 * j) * (*(const f32x4*)(sc + 256 * j) + 1.0f); g[0] = gclamp(g[0]); g[1] = gclamp(g[1]); g[2] = gclamp(g[2]); g[3] = gclamp(g[3]); const f32x4 o = v[q][j] * g;
                u32x2 w; w.x = pk2(o[0], o[1]); w.y = pk2(o[2], o[3]); *(u32x2*)(AP + (size_t)row * 1024 + 4 * lane + 256 * j) = w; } } }
    }
}

constexpr int ATT_KS = 144, ATT_VS = 260, ATT_VOFF = 256 * ATT_KS;
__device__ __forceinline__ void attn_phase(LAS unsigned char* lds, const bf16_t* Q, const bf16_t* K, const bf16_t* V, bf16_t* O, const float* sinks, int tid, int lane, int wid, int u_first, int u_end, int u_step) {
    const int q32 = lane & 31, hi = lane >> 5;
    const float NEG = -__builtin_inff();
    for (int unit = u_first; unit < u_end; unit += u_step) {
        const int qb = unit & 15, kvh = (unit >> 4) & 3, b = unit >> 6;
        const size_t rowbase = (size_t)b * SEQ; const int kstart = (qb - 1) * 128;
        __syncthreads();
#pragma unroll
        for (int i = 0; i < 4; ++i) { const int idx = tid + 512 * i, row = idx >> 3, ch = idx & 7, kr = kstart + row;
            u32x4 kv = {0u, 0u, 0u, 0u}, vv = {0u, 0u, 0u, 0u};
            if (kr >= 0) { kv = *(const u32x4*)(K + (rowbase + kr) * 256 + kvh * 64 + ch * 8); vv = *(const u32x4*)(V + (rowbase + kr) * 256 + kvh * 64 + ch * 8); }
            *(LAS u32x4*)(lds + row * ATT_KS + ch * 16) = kv;
            LAS bf16_t* vt = (LAS bf16_t*)(lds + ATT_VOFF) + (ch * 8) * ATT_VS + row;
#pragma unroll
            for (int e = 0; e < 8; ++e) vt[e * ATT_VS] = (bf16_t)((vv[e >> 1] >> (16 * (e & 1))) & 0xffffu);
        }
        __syncthreads();
        const int head = kvh * 4 + (wid >> 1), h2 = wid & 1;
        const float sink2 = sinks[head] * 1.44269504f;
#pragma unroll 1
        for (int qi = 0; qi < 2; ++qi) {
            const int qo = 64 * h2 + 32 * qi, kt0 = qo >> 5;
            const size_t qrow = rowbase + qb * 128 + qo + q32;
            bf16x8 qr[4];
#pragma unroll
            for (int ks = 0; ks < 4; ++ks) qr[ks] = *(const bf16x8*)(Q + qrow * 1024 + head * 64 + ks * 16 + hi * 8);
            f32x16 s[5];
#pragma unroll
            for (int j = 0; j < 5; ++j) {
                const int kt = kt0 + j;
                f32x16 acc = {0.f, 0.f, 0.f, 0.f, 0.f, 0.f, 0.f, 0.f, 0.f, 0.f, 0.f, 0.f, 0.f, 0.f, 0.f, 0.f};
#pragma unroll
                for (int ks = 0; ks < 4; ++ks) { const bf16x8 ka = *(const LAS bf16x8*)(lds + (32 * kt + q32) * ATT_KS + ks * 32 + hi * 16);
                    acc = __builtin_amdgcn_mfma_f32_32x32x16_bf16(ka, qr[ks], acc, 0, 0, 0); }
                const bool dead = (qb == 0) && (kt < 4);
#pragma unroll
                for (int r = 0; r < 16; ++r) { const int key = (r & 3) + 8 * (r >> 2) + 4 * hi;
                    bool ok = !dead;
                    if (j == 0) ok = ok && (q32 < key);
                    if (j == 4) ok = ok && (key <= q32);
                    acc[r] = ok ? acc[r] : NEG; }
                s[j] = acc;
            }
            float mx = sink2;
#pragma unroll
            for (int j = 0; j < 5; ++j)
#pragma unroll
                for (int r = 0; r < 16; ++r) mx = fmaxf(mx, s[j][r]);
            mx = fmaxf(mx, __shfl_xor(mx, 32));
            float l = 0.f;
#pragma unroll
            for (int j = 0; j < 5; ++j)
#pragma unroll
                for (int r = 0; r < 16; ++r) { const float p = __builtin_amdgcn_exp2f(s[j][r] - mx); s[j][r] = p; l += p; }
            l += __shfl_xor(l, 32);
            l += __builtin_amdgcn_exp2f(sink2 - mx);
            f32x16 o[2];
#pragma unroll
            for (int db = 0; db < 2; ++db) o[db] = (f32x16){0.f, 0.f, 0.f, 0.f, 0.f, 0.f, 0.f, 0.f, 0.f, 0.f, 0.f, 0.f, 0.f, 0.f, 0.f, 0.f};
#pragma unroll
            for (int j = 0; j < 5; ++j) {
                const int kt = kt0 + j;
#pragma unroll
                for (int st = 0; st < 2; ++st) {
                    u32x4 pw; pw.x = pg8::cvt_pk_bf16(s[j][8 * st + 0], s[j][8 * st + 1]); pw.y = pg8::cvt_pk_bf16(s[j][8 * st + 2], s[j][8 * st + 3]);
                    pw.z = pg8::cvt_pk_bf16(s[j][8 * st + 4], s[j][8 * st + 5]); pw.w = pg8::cvt_pk_bf16(s[j][8 * st + 6], s[j][8 * st + 7]);
                    const bf16x8 pb = __builtin_bit_cast(bf16x8, pw);
#pragma unroll
                    for (int db = 0; db < 2; ++db) {
                        const LAS unsigned char* vp = lds + ATT_VOFF + ((q32 + 32 * db) * ATT_VS + 32 * kt + 16 * st + 4 * hi) * 2;
                        const s16x4 lo = *(const LAS s16x4*)(vp), hh = *(const LAS s16x4*)(vp + 16);
                        const bf16x8 va = {lo[0], lo[1], lo[2], lo[3], hh[0], hh[1], hh[2], hh[3]};
                        o[db] = __builtin_amdgcn_mfma_f32_32x32x16_bf16(va, pb, o[db], 0, 0, 0);
                    }
                }
            }
            const float inv = 1.0f / l;
            bf16_t* op = O + qrow * 1024 + head * 64 + 4 * hi;
#pragma unroll
            for (int db = 0; db < 2; ++db)
#pragma unroll
                for (int rq = 0; rq < 4; ++rq) { u32x2 w; w.x = pg8::cvt_pk_bf16(o[db][4 * rq] * inv, o[db][4 * rq + 1] * inv); w.y = pg8::cvt_pk_bf16(o[db][4 * rq + 2] * inv, o[db][4 * rq + 3] * inv);
                    *(u32x2*)(op + 32 * db + 8 * rq) = w; }
        }
    }
}

__device__ __forceinline__ void unpack8(u32x4 w, float (&f)[8]) {
#pragma unroll
    for (int i = 0; i < 4; ++i) { f[2 * i] = bf_lo(w[i]); f[2 * i + 1] = bf_hi(w[i]); }
}
__device__ __forceinline__ void conv_phase(const bf16_t* U, const bf16_t* GB, bf16_t* A2, const float* cw, int tid, int t_first, int t_end, int t_step) {
    const int c8 = (tid & 127) * 8, chunk = tid >> 7;
    float w0[8], w1[8], w2[8];
#pragma unroll
    for (int e = 0; e < 8; ++e) { w0[e] = cw[c8 + e]; w1[e] = cw[1024 + c8 + e]; w2[e] = cw[2048 + c8 + e]; }
    for (int task = t_first; task < t_end; task += t_step) {
        const int rstart = task * 64 + chunk * 16, t0 = rstart & (SEQ - 1);
        float um2[8], um1[8];
        if (t0 > 0) { unpack8(*(const u32x4*)(U + (size_t)(rstart - 2) * 1024 + c8), um2); unpack8(*(const u32x4*)(U + (size_t)(rstart - 1) * 1024 + c8), um1); }
        else {
#pragma unroll
            for (int e = 0; e < 8; ++e) { um2[e] = 0.f; um1[e] = 0.f; } }
#pragma unroll 4
        for (int i = 0; i < 16; ++i) {
            const size_t off = (size_t)(rstart + i) * 1024 + c8;
            float uc[8], g[8], y[8]; unpack8(*(const u32x4*)(U + off), uc); unpack8(*(const u32x4*)(GB + off), g);
#pragma unroll
            for (int e = 0; e < 8; ++e) { y[e] = g[e] * (w0[e] * um2[e] + w1[e] * um1[e] + w2[e] * uc[e]); um2[e] = um1[e]; um1[e] = uc[e]; }
            u32x4 w; w.x = pk2(y[0], y[1]); w.y = pk2(y[2], y[3]); w.z = pk2(y[4], y[5]); w.w = pk2(y[6], y[7]);
            *(u32x4*)(A2 + off) = w;
        }
    }
}

__device__ __forceinline__ void xcc_barrier(unsigned* bar, unsigned x, unsigned nloc) {
    asm volatile("s_waitcnt vmcnt(0)" ::: "memory");
    __syncthreads();
    if (threadIdx.x == 0) {
        __builtin_amdgcn_s_waitcnt(0);
        const unsigned old = xb_add(&bar[XB_XSUB(x)], 1u);
        const unsigned gen = old / nloc;
        if (old + 1u == (gen + 1u) * nloc) xb_add(&bar[XB_XGEN(x)], 1u);
        else XB_SPIN(xb_ld(&bar[XB_XGEN(x)]) == gen, bar);
        __builtin_amdgcn_fence(__ATOMIC_ACQUIRE, "agent");
        asm volatile("s_waitcnt vmcnt(0)" ::: "memory");
    }
    __syncthreads();
}

__device__ __forceinline__ void grid_seam() {
    asm volatile("s_waitcnt vmcnt(0) lgkmcnt(0)" ::: "memory");
    __syncthreads();
    cg::this_grid().sync();
    __builtin_amdgcn_fence(__ATOMIC_ACQUIRE, "agent");
    asm volatile("s_waitcnt vmcnt(0)" ::: "memory");
}
#ifndef MK_MULTI
#define MK_MULTI 0
#endif
#ifndef LAYER_STEPS
#define LAYER_STEPS {0, 1, 2, 3, 4, 5, 6}
#endif
__device__ const int LSTEP[] = LAYER_STEPS;
constexpr int NLS = sizeof(LSTEP) / sizeof(int);
#ifndef REP_PRO
#define REP_PRO 1
#endif
#ifndef REP_P0B
#define REP_P0B 1
#endif
__global__ void __launch_bounds__(NTHREADS, 2) mk_fwd(Args a) {
    extern __shared__ __attribute__((aligned(16))) unsigned char lds_raw[];
    LAS unsigned char* lds = (LAS unsigned char*)lds_raw;
    unsigned char* ws = a.ws;
    volatile LAS unsigned* bst = (volatile LAS unsigned*)(lds + 131072 + 512);
    if (threadIdx.x == 0) { bst[0] = 0u; bst[1] = 0u; }
    __syncthreads();
    {
        int tid = threadIdx.x; asm volatile("" : "+v"(tid)); const int lane = tid & 63, wid = __builtin_amdgcn_readfirstlane(tid >> 6);
#ifndef NO_P0A
        for (int rep = 0; rep < REP_PRO; ++rep) { p0a(a, lds, tid, lane, wid); __syncthreads(); }
#endif
        grid_seam();
    }
    if (threadIdx.x == 0) bst[2] = xb_add((unsigned*)(ws + WS_BARW) + XB_XCNT(xb_xcc_id()), 1u);
#define XBAR() do { XcdBarrier xb_; xb_.bar = (unsigned*)(ws + WS_BARW); xb_.x = xb_xcc_id(); xb_.st = bst; xcd_barrier(xb_); } while (0)
    {
        int tid = threadIdx.x; asm volatile("" : "+v"(tid)); const int lane = tid & 63, wid = __builtin_amdgcn_readfirstlane(tid >> 6);
#ifndef NO_P0B
        for (int rep = 0; rep < REP_P0B; ++rep) p0b(a, tid, lane, wid);
#endif
        XBAR();
    }
    if (threadIdx.x == 0) { unsigned* bw = (unsigned*)(ws + WS_BARW); bool reg = (gridDim.x == 256u);
        for (unsigned j = 0; j < 8; ++j) reg = reg && (xb_ld(&bw[XB_XCNT(j)]) == 32u);
#ifdef FORCE_GLOBAL
        reg = false;
#endif
        const unsigned x = xb_xcc_id();
        bst[3] = reg ? 1u : 0u; bst[4] = reg ? bst[2] * 8u + x : (unsigned)blockIdx.x; bst[5] = x; }
    __syncthreads();
    const float* xin = (const float*)a.in[0]; float* const outp = a.out;
    for (int it = 0; it < DEPTH * NLS; ++it) {
        unsigned char* ws = a.ws; asm volatile("" : "+s"(ws));
#define SLAB_EL ((size_t)12 * MiB)
#define TBASE(off_el, pitch, flat_el) (BST(3) ? BIG + (size_t)BST(5) * SLAB_EL + (size_t)(off_el) - (size_t)BST(5) * 4096 * (pitch) : BIG + (size_t)(flat_el))
#define T_ACT TBASE(0, DFF, 0)
#define T_Q   TBASE(0, 1024, 0)
#define T_K   TBASE(4 * MiB, 256, 32 * MiB)
#define T_V   TBASE(5 * MiB, 256, 40 * MiB)
#define T_ATT TBASE(6 * MiB, 1024, 48 * MiB)
#define T_U   TBASE(0, 1024, 0)
#define T_GB  TBASE(4 * MiB, 1024, (size_t)MROWS * 1024)
#define T_A2  TBASE(8 * MiB, 1024, (size_t)2 * MROWS * 1024)
#define BST(i) __builtin_amdgcn_readfirstlane((int)bst[i])
        float* rs = (float*)(ws + WS_RS); const float* sbt = (const float*)(ws + WS_SB);
        bf16_t* AP = (bf16_t*)(ws + WS_AP); bf16_t* BIG = (bf16_t*)(ws + WS_BIG);
        const float* GT = (const float*)(ws + WS_GT); const float* GATE = (const float*)(ws + WS_GATE);
        const float* par = (const float*)(ws + WS_PAR);
        int tid = threadIdx.x; asm volatile("" : "+v"(tid));
        const int lane = tid & 63, wid = __builtin_amdgcn_readfirstlane(tid >> 6);
        {
            const int l = it / NLS, k = LSTEP[it % NLS], s0 = 3 * l, jx = l >> 1;
            if (k == 0 || k == 5) {
                const int i = (k == 5), s = s0 + 2 * i;
                pg8::Gemm g{AP, (const bf16_t*)(ws + WS_UP) + (size_t)(2 * l + i) * NUP * 1024, MROWS, NUP, 1024};
                pg8::StaticOrder S; S.init(MROWS, NUP, gridDim.x, BST(4));
                pg8::EpiUp E{T_ACT, rs, sbt + (size_t)s * SB_STRIDE, (LAS float*)(lds + 131072 + 1024), -1};
                #ifndef NO_UP
                pg8::gemm_phase<pg8::EpiUp, pg8::StaticOrder, true, true>(lds, g, S, E, tid);
#endif
            } else if (k == 1 || k == 6 || k == 4) {
                pg8::Gemm g; pg8::EpiResid E;
                const int ridx = 3 * l + (k == 1 ? 0 : (k == 4 ? 1 : 2));
                E.out = (ridx == 3 * DEPTH - 1) ? outp : nullptr;
                E.AP_in = AP; E.RGp = (const float*)(ws + WS_XALT) + (size_t)ridx * 16384; E.AP = AP; E.bias = nullptr;
                if (k == 4) {
                    g = pg8::Gemm{(l & 1) ? T_A2 : T_ATT, (l & 1) ? (const bf16_t*)(ws + WS_COUT) + (size_t)jx * 1024 * 1024 : (const bf16_t*)(ws + WS_O) + (size_t)jx * 1024 * 1024, MROWS, 1024, 1024};
                    E.gate = GATE + (s0 + 1) * 16384; if (!(l & 1)) E.bias = par + PAR_BO + jx * 1024;
                    E.Gn = GT + (s0 + 2) * 16384; E.nrowss = rs;
                } else {
                    const int i = (k == 6);
                    g = pg8::Gemm{T_ACT, (const bf16_t*)(ws + WS_DN) + (size_t)(2 * l + i) * 1024 * DFF, MROWS, 1024, DFF};
                    E.gate = GATE + (s0 + 2 * i) * 16384;
                    if (!i) { E.Gn = GT + (s0 + 1) * 16384; E.nrowss = rs; }
                    else if (l < DEPTH - 1) { E.Gn = GT + (s0 + 3) * 16384; E.nrowss = rs; }
                    else { E.AP = nullptr; E.Gn = GT; E.nrowss = rs; }
                }
                pg8::StaticOrder S; S.init(MROWS, 1024, gridDim.x, BST(4));
                #ifndef NO_RES
                pg8::gemm_phase<pg8::EpiResid, pg8::StaticOrder, true, true>(lds, g, S, E, tid);
#endif
            } else if (k == 2) {
                if (!(l & 1)) {
                    pg8::Gemm g{AP, (const bf16_t*)(ws + WS_QKV) + (size_t)jx * NQKV * 1024, MROWS, NQKV, 1024};
                    pg8::StaticOrder S; S.init(MROWS, NQKV, gridDim.x, BST(4));
                    pg8::EpiQKV E{T_Q, T_K, T_V, rs, sbt + (size_t)(s0 + 1) * SB_STRIDE,
                                  par + PAR_QG + jx * 64, par + PAR_KG + jx * 64, (const float*)(ws + WS_COS), (const float*)(ws + WS_SIN)};
                    #ifndef NO_QKV
                    pg8::gemm_phase<pg8::EpiQKV, pg8::StaticOrder, true, true>(lds, g, S, E, tid);
#endif
                } else {
                    pg8::Gemm g{AP, (const bf16_t*)(ws + WS_CIN) + (size_t)jx * NCIN * 1024, MROWS, NCIN, 1024};
                    pg8::StaticOrder S; S.init(MROWS, NCIN, gridDim.x, BST(4));
                    pg8::EpiCin E{T_U, T_GB, rs, sbt + (size_t)(s0 + 1) * SB_STRIDE};
                    #ifndef NO_CIN
                    pg8::gemm_phase<pg8::EpiCin, pg8::StaticOrder, true, true>(lds, g, S, E, tid);
#endif
                }
            } else {
#ifndef NO_ATT
                if (!(l & 1)) attn_phase(lds, T_Q, T_K, T_V, T_ATT, par + PAR_SINK + jx * 16, tid, lane, wid, BST(3) ? BST(5) * 128 + (BST(4) >> 3) : (int)blockIdx.x, BST(3) ? BST(5) * 128 + 128 : NBATCH * 64, BST(3) ? 32 : (int)gridDim.x);
                else
#endif
#ifndef NO_CONV
                conv_phase(T_U, T_GB, T_A2, par + PAR_CW + jx * 3 * 1024, tid, BST(3) ? BST(5) * 64 + (BST(4) >> 3) : (int)blockIdx.x, BST(3) ? BST(5) * 64 + 64 : MROWS / 64, BST(3) ? 32 : (int)gridDim.x);
#endif
                ;
            }
        }
        if (it + 1 < DEPTH * NLS) { unsigned char* ws = a.ws; asm volatile("" : "+s"(ws));
            if (__builtin_amdgcn_readfirstlane((int)bst[3])) xcc_barrier((unsigned*)(ws + WS_BARW), (unsigned)__builtin_amdgcn_readfirstlane((int)bst[5]), 32u); else XBAR();
#ifdef DOUBLE_SEAM
            XBAR(); XBAR();
#endif
        }
    }
}

extern "C" void kernel_launch(void* const* d_in, const int* in_sizes, int n_in, void* d_out, int out_size, void* d_ws, size_t ws_size, hipStream_t stream) {
    static int grid = 0;
    if (grid == 0) {
        if (n_in != 18 || out_size != MROWS * DM || ws_size < WS_END) { fprintf(stderr, "kernel_launch: unexpected problem (n_in %d, out %d, ws %zu); nothing launched\n", n_in, out_size, ws_size); grid = -1; return; }
        int dev = 0, cus = 0, per_cu = 0;
        if (hipGetDevice(&dev) != hipSuccess || hipDeviceGetAttribute(&cus, hipDeviceAttributeMultiprocessorCount, dev) != hipSuccess) { grid = -1; return; }
        if (hipFuncSetAttribute((const void*)mk_fwd, hipFuncAttributeMaxDynamicSharedMemorySize, LDS_BYTES) != hipSuccess) { fprintf(stderr, "kernel_launch: hipFuncSetAttribute failed\n"); grid = -1; return; }
        if (hipOccupancyMaxActiveBlocksPerMultiprocessor(&per_cu, (const void*)mk_fwd, NTHREADS, LDS_BYTES) != hipSuccess || per_cu < 1) { fprintf(stderr, "kernel_launch: occupancy query says %d\n", per_cu); per_cu = 1; }
        (void)hipGetLastError();
        grid = cus * per_cu;
    }
    if (grid < 0) return;
    Args a{};
    for (int i = 0; i < 18; ++i) a.in[i] = d_in[i];
    a.out = (float*)d_out; a.ws = (unsigned char*)d_ws;
#if MK_MULTI
    for (int ph = 0; ph < NPH; ++ph) { a.ph_lo = ph; a.ph_hi = ph + 1; hipLaunchKernelGGL(mk_fwd, dim3(grid), dim3(NTHREADS), LDS_BYTES, stream, a); }
#else
    a.ph_lo = 0; a.ph_hi = NPH;
    void* args[] = {&a};
    hipError_t e = hipLaunchCooperativeKernel((const void*)mk_fwd, dim3(grid), dim3(NTHREADS), args, LDS_BYTES, stream);
    if (e != hipSuccess) fprintf(stderr, "cooperative launch failed: %s (grid %d)\n", hipGetErrorString(e), grid);
#endif
}
```

```cpp
#include <hip/hip_runtime.h>
#include <hip/hip_cooperative_groups.h>
#include <cstdio>
#include <cstdint>
namespace cg = cooperative_groups;
namespace pg8 {
#define PG8_LAS __attribute__((address_space(3)))
typedef unsigned short bf16_t;
typedef short bf16x8 __attribute__((ext_vector_type(8)));
typedef float f32x4 __attribute__((ext_vector_type(4)));
typedef unsigned u32x4 __attribute__((ext_vector_type(4)));
constexpr int BM = 256, BK = 64, HALF = 128, HTB = HALF * BK * 2  , STAGE_BYTES = 8 * HTB, NXCD = 8, WGM = 8;

__host__ __device__ __forceinline__ int lds_byte(int r, int c) { const int st = (r >> 4) * 2 + (c >> 5), rr = r & 15, cc = c & 31, ob = rr * 64 + cc * 2; return st * 1024 + (ob ^ (((ob >> 9) & 1) << 5)); }
__host__ __device__ __forceinline__ void stage_rc(int b, int& R, int& C) { const int st = b / 1024, sb = b % 1024, swz = sb ^ (((sb >> 9) & 1) << 5); R = (st >> 1) * 16 + swz / 64; C = (st & 1) * 32 + (swz % 64) / 2; }
__host__ __device__ __forceinline__ int perm32(int rho) { const int n = rho >> 4, i = rho & 15; return 8 * (i >> 2) + 4 * n + (i & 3); }

struct Unit { int pm, pn; };
struct Gemm { const bf16_t* A; const bf16_t* Bt; int M, N, K; };

struct StaticOrder {
    int nM, nN, nwg, G, c;
    __host__ __device__ void init(int M, int N, int G_, int c_) { nM = M / BM; nN = N / BM; nwg = nM * nN; G = G_; c = c_; }
    __host__ __device__ bool next(int i, Unit& u) const {
        const long L = (long)i * G + c; if (L >= nwg) return false;
        int wgid = (int)L; { const int q = nwg / NXCD, r = nwg % NXCD, xcd = wgid % NXCD, off = wgid / NXCD; wgid = (xcd < r ? xcd * (q + 1) : r * (q + 1) + (xcd - r) * q) + off; }
        const int nig = WGM * nN, gid = wgid / nig, fm = gid * WGM, gsz = (nM - fm) < WGM ? (nM - fm) : WGM;
        u.pm = fm + ((wgid % nig) % gsz); u.pn = (wgid % nig) / gsz; return true;
    }
    __device__ __forceinline__ void a_ready(const Unit&) const {}
    __device__ __forceinline__ void done(const Unit&) const {}
};

typedef float f32x2 __attribute__((ext_vector_type(2)));
typedef __bf16 bf16x2_t __attribute__((ext_vector_type(2)));
__device__ __forceinline__ unsigned cvt_pk_bf16(float lo, float hi) { const f32x2 v = {lo, hi}; const bf16x2_t b = __builtin_convertvector(v, bf16x2_t); return __builtin_bit_cast(unsigned, b); }
typedef unsigned u32x2 __attribute__((ext_vector_type(2)));
#define PG8_GAS __attribute__((address_space(1)))
__device__ __forceinline__ f32x4 ld4(const float* p) { return *(const PG8_GAS f32x4*)p; }
__device__ __forceinline__ u32x4 ld4u(const void* p) { return *(const PG8_GAS u32x4*)p; }
__device__ __forceinline__ void st4f(float* p, f32x4 v) { *(PG8_GAS f32x4*)p = v; }
__device__ __forceinline__ void st4u(void* p, u32x4 v) { *(PG8_GAS u32x4*)p = v; }
__device__ __forceinline__ u32x4 pack8(f32x4 a, f32x4 b) { u32x4 w; w.x = cvt_pk_bf16(a[0], a[1]); w.y = cvt_pk_bf16(a[2], a[3]); w.z = cvt_pk_bf16(b[0], b[1]); w.w = cvt_pk_bf16(b[2], b[3]); return w; }
__device__ __forceinline__ float silu_f(float g) { return g * __builtin_amdgcn_rcpf(1.f + __builtin_amdgcn_exp2f(-1.44269504f * g)); }
__device__ __forceinline__ float rstd_of(float ss, float inv_n) { return 1.0f / sqrtf(ss * inv_n + 1e-6f); }
__device__ __forceinline__ float rstd_row(const float* rsp, int row) {
    const f32x4 a = ld4(rsp + (size_t)row * 16), b = ld4(rsp + (size_t)row * 16 + 4), c = ld4(rsp + (size_t)row * 16 + 8), d = ld4(rsp + (size_t)row * 16 + 12);
    const float s = (((a[0] + a[1]) + (a[2] + a[3])) + ((b[0] + b[1]) + (b[2] + b[3]))) + (((c[0] + c[1]) + (c[2] + c[3])) + ((d[0] + d[1]) + (d[2] + d[3])));
    return rstd_of(s, 1.f / 1024.f);
}

__device__ __forceinline__ void rstd8(const float* rsp, int row0, int fq, float (&r)[2][4]) {
    f32x4 p[2][4];
#pragma unroll
    for (int ai = 0; ai < 2; ++ai)
#pragma unroll
        for (int m = 0; m < 4; ++m) p[ai][m] = ld4(rsp + (size_t)(row0 + ai * 128 + m * 16) * 16 + 4 * fq);
#pragma unroll
    for (int ai = 0; ai < 2; ++ai)
#pragma unroll
        for (int m = 0; m < 4; ++m) { float s = (p[ai][m][0] + p[ai][m][1]) + (p[ai][m][2] + p[ai][m][3]); s += __shfl_xor(s, 16); s += __shfl_xor(s, 32);
            r[ai][m] = __builtin_amdgcn_rsqf(s * (1.f / 1024.f) + 1e-6f); }
}

struct EpiUp {
    static constexpr bool PERM = true, AFTER_DRAIN = false;
    bf16_t* O; const float* rowss; const float* sb; PG8_LAS float* rl; mutable int last_pm;
    __device__ __forceinline__ void operator()(const f32x4 (&acc)[2][2][4][2], const Unit& u, int wr, int wc, int fr, int fq) const {
        const int b = u.pm >> 3;
        const float* sbp = sb + (size_t)b * 5632 + u.pn * 256 + wc * 32 + 8 * fq;
        f32x4 sg[2], su[2];
#pragma unroll
        for (int n = 0; n < 2; ++n) { sg[n] = ld4(sbp + 4 * n); su[n] = ld4(sbp + 128 + 4 * n); }
        const int row0 = u.pm * 256 + wr * 64 + fr;
        bf16_t* ob = O + u.pn * 128 + wc * 32 + 8 * fq;
        float rr[2][4];
        PG8_LAS float* rw = rl + (wr * 4 + wc) * 128 + fr;
        if (u.pm != last_pm) {
            rstd8(rowss, row0, fq, rr);
            if (fq == 0) {
#pragma unroll
                for (int ai = 0; ai < 2; ++ai)
#pragma unroll
                    for (int m = 0; m < 4; ++m) rw[(ai * 4 + m) * 16] = rr[ai][m]; }
            last_pm = u.pm;
        } else {
#pragma unroll
            for (int ai = 0; ai < 2; ++ai)
#pragma unroll
                for (int m = 0; m < 4; ++m) rr[ai][m] = rw[(ai * 4 + m) * 16];
        }
#pragma unroll
        for (int ai = 0; ai < 2; ++ai)
#pragma unroll
            for (int m = 0; m < 4; ++m) {
                const int row = row0 + ai * 128 + m * 16; const float r = rr[ai][m]; const f32x2 r2 = {r, r};
                u32x4 w;
#pragma unroll
                for (int n = 0; n < 2; ++n) { const f32x4 ga = acc[ai][0][m][n], ua = acc[ai][1][m][n];
#pragma unroll
                    for (int h = 0; h < 2; ++h) {
                        const f32x2 g2 = (f32x2){ga[2 * h], ga[2 * h + 1]} * r2 + (f32x2){sg[n][2 * h], sg[n][2 * h + 1]};
                        const f32x2 u2 = (f32x2){ua[2 * h], ua[2 * h + 1]} * r2 + (f32x2){su[n][2 * h], su[n][2 * h + 1]};
                        const f32x2 t2 = g2 * (-1.44269504f);
                        f32x2 d2; d2.x = __builtin_amdgcn_exp2f(t2.x); d2.y = __builtin_amdgcn_exp2f(t2.y); d2 = d2 + 1.0f;
                        f32x2 q2; q2.x = __builtin_amdgcn_rcpf(d2.x); q2.y = __builtin_amdgcn_rcpf(d2.y);
                        const f32x2 a2 = (g2 * u2) * q2;
                        w[2 * n + h] = cvt_pk_bf16(a2.x, a2.y); } }
                st4u(ob + (size_t)row * 2816, w);
            }
    }
};

__device__ __forceinline__ f32x4 bf4_lo(u32x4 w) { f32x4 r; r[0] = __builtin_bit_cast(float, w[0] << 16); r[1] = __builtin_bit_cast(float, w[0] & 0xffff0000u); r[2] = __builtin_bit_cast(float, w[1] << 16); r[3] = __builtin_bit_cast(float, w[1] & 0xffff0000u); return r; }
__device__ __forceinline__ f32x4 bf4_hi(u32x4 w) { f32x4 r; r[0] = __builtin_bit_cast(float, w[2] << 16); r[1] = __builtin_bit_cast(float, w[2] & 0xffff0000u); r[2] = __builtin_bit_cast(float, w[3] << 16); r[3] = __builtin_bit_cast(float, w[3] & 0xffff0000u); return r; }
struct EpiResid {
    static constexpr bool PERM = true, AFTER_DRAIN = false;
    const bf16_t* AP_in; float* out; const float* gate; const float* bias;
    bf16_t* AP; const float* Gn; const float* RGp; float* nrowss;
    __device__ __forceinline__ void operator()(const f32x4 (&acc)[2][2][4][2], const Unit& u, int wr, int wc, int fr, int fq) const {
        const int b = u.pm >> 3;
        const int col0 = u.pn * 256 + wc * 32 + 8 * fq;
        f32x4 gt[2][2], G[2][2], rg[2][2];
#pragma unroll
        for (int bj = 0; bj < 2; ++bj)
#pragma unroll
            for (int n = 0; n < 2; ++n) { const int c = col0 + 128 * bj + 4 * n;
                gt[bj][n] = ld4(gate + b * 1024 + c);
                G[bj][n] = AP ? ld4(Gn + b * 1024 + c) : (f32x4){0.f, 0.f, 0.f, 0.f};
                rg[bj][n] = ld4(RGp + b * 1024 + c); }
        const int row0 = u.pm * 256 + wr * 64 + fr;
        u32x4 wn[2];
#pragma unroll
        for (int bj = 0; bj < 2; ++bj) wn[bj] = ld4u(AP_in + (size_t)row0 * 1024 + col0 + 128 * bj);
#pragma unroll
        for (int r = 0; r < 8; ++r) {
            const int ai = r >> 2, m = r & 3;
            const int row = row0 + ai * 128 + m * 16; const size_t off = (size_t)row * 1024 + col0; float ss = 0.f;
            u32x4 wcur[2];
#pragma unroll
            for (int bj = 0; bj < 2; ++bj) wcur[bj] = wn[bj];
            if (r < 7) { const size_t offn = (size_t)(row0 + ((r + 1) >> 2) * 128 + ((r + 1) & 3) * 16) * 1024 + col0;
#pragma unroll
                for (int bj = 0; bj < 2; ++bj) wn[bj] = ld4u(AP_in + offn + 128 * bj); }
#pragma unroll
            for (int bj = 0; bj < 2; ++bj) { f32x4 xin[2], xn[2];
                xin[0] = bf4_lo(wcur[bj]) * rg[bj][0]; xin[1] = bf4_hi(wcur[bj]) * rg[bj][1];
#pragma unroll
                for (int n = 0; n < 2; ++n) { f32x4 y = acc[ai][bj][m][n]; if (bias) y = y + ld4(bias + col0 + 128 * bj + 4 * n); xn[n] = xin[n] + gt[bj][n] * y;
                    ss += (xn[n][0] * xn[n][0] + xn[n][1] * xn[n][1]) + (xn[n][2] * xn[n][2] + xn[n][3] * xn[n][3]); }
                if (out) { st4f(out + off + 128 * bj, xn[0]); st4f(out + off + 128 * bj + 4, xn[1]); }
                if (AP) st4u(AP + off + 128 * bj, pack8(xn[0] * G[bj][0], xn[1] * G[bj][1])); }
            if (AP) { ss += __shfl_xor(ss, 16); ss += __shfl_xor(ss, 32); if (fq == 0) *(PG8_GAS float*)(nrowss + (size_t)row * 16 + u.pn * 4 + wc) = ss; }
            asm volatile("" ::: "memory");
        }
    }
};

struct EpiQKV {
    static constexpr bool PERM = true, AFTER_DRAIN = false;
    bf16_t *Q, *K, *V; const float* rowss; const float* sb; const float* qg; const float* kg; const float* cosT; const float* sinT;
    __device__ __forceinline__ void operator()(const f32x4 (&acc)[2][2][4][2], const Unit& u, int wr, int wc, int fr, int fq) const {
        const int b = u.pm >> 3;
        const float* sbp = sb + (size_t)b * 1536 + u.pn * 256 + wc * 32 + 8 * fq;
        f32x4 sv[2][2], gv[2][2];
        const int typ = u.pn < 4 ? 0 : (u.pn == 4 ? 1 : 2);
        const float* gp = (typ == 0 ? qg : kg) + 8 * fq;
#pragma unroll
        for (int bj = 0; bj < 2; ++bj)
#pragma unroll
            for (int n = 0; n < 2; ++n) { sv[bj][n] = ld4(sbp + 128 * bj + 4 * n); gv[bj][n] = ld4(gp + 32 * bj + 4 * n); }
        const int row0 = u.pm * 256 + wr * 64 + fr;
        float rr[2][4]; rstd8(rowss, row0, fq, rr);
        bf16_t* dst; int pitch; float osc = 1.f;
        if (typ == 0) { dst = Q + (u.pn * 4 + wc) * 64 + 8 * fq; pitch = 1024; osc = 0.125f * 1.44269504f; }
        else if (typ == 1) { dst = K + wc * 64 + 8 * fq; pitch = 256; }
        else { dst = V + wc * 64 + 8 * fq; pitch = 256; }
#pragma unroll
        for (int ai = 0; ai < 2; ++ai)
#pragma unroll
            for (int m = 0; m < 4; ++m) {
                const int row = row0 + ai * 128 + m * 16; const float r = rr[ai][m];
                f32x4 v[2][2]; float ss = 0.f;
#pragma unroll
                for (int bj = 0; bj < 2; ++bj)
#pragma unroll
                    for (int n = 0; n < 2; ++n) { v[bj][n] = acc[ai][bj][m][n] * r + sv[bj][n];
                        ss += (v[bj][n][0] * v[bj][n][0] + v[bj][n][1] * v[bj][n][1]) + (v[bj][n][2] * v[bj][n][2] + v[bj][n][3] * v[bj][n][3]); }
                bf16_t* dp = dst + (size_t)row * pitch;
                if (typ == 2) {
                    st4u(dp, pack8(v[0][0], v[0][1])); st4u(dp + 32, pack8(v[1][0], v[1][1]));
                } else {
                    ss += __shfl_xor(ss, 16); ss += __shfl_xor(ss, 32);
                    const float rn = rstd_of(ss, 1.f / 64.f) * osc;
                    f32x4 o1[2], o2[2];
#pragma unroll
                    for (int n = 0; n < 2; ++n) { const f32x4 cs = ld4(cosT + (size_t)row * 32 + 8 * fq + 4 * n), sn = ld4(sinT + (size_t)row * 32 + 8 * fq + 4 * n);
                        const f32x4 y1 = v[0][n] * gv[0][n] * rn, y2 = v[1][n] * gv[1][n] * rn;
                        o1[n] = y1 * cs - y2 * sn; o2[n] = y2 * cs + y1 * sn; }
                    st4u(dp, pack8(o1[0], o1[1])); st4u(dp + 32, pack8(o2[0], o2[1]));
                }
            }
    }
};

struct EpiCin {
    static constexpr bool PERM = true, AFTER_DRAIN = false;
    bf16_t *U, *GB; const float* rowss; const float* sb;
    __device__ __forceinline__ void operator()(const f32x4 (&acc)[2][2][4][2], const Unit& u, int wr, int wc, int fr, int fq) const {
        const int b = u.pm >> 3;
        const float* sbp = sb + (size_t)b * 3072 + u.pn * 256 + wc * 32 + 8 * fq;
        f32x4 sv[2][2];
#pragma unroll
        for (int bj = 0; bj < 2; ++bj)
#pragma unroll
            for (int n = 0; n < 2; ++n) sv[bj][n] = ld4(sbp + 128 * bj + 4 * n);
        const int row0 = u.pm * 256 + wr * 64 + fr;
        float rr[2][4]; rstd8(rowss, row0, fq, rr);
        const bool isu = u.pn < 8;
        bf16_t* ob = isu ? U + u.pn * 128 + wc * 32 + 8 * fq : GB + (u.pn - 8) * 256 + wc * 32 + 8 * fq;
#pragma unroll
        for (int ai = 0; ai < 2; ++ai)
#pragma unroll
            for (int m = 0; m < 4; ++m) {
                const int row = row0 + ai * 128 + m * 16; const float r = rr[ai][m];
                f32x4 v[2][2];
#pragma unroll
                for (int bj = 0; bj < 2; ++bj)
#pragma unroll
                    for (int n = 0; n < 2; ++n) v[bj][n] = acc[ai][bj][m][n] * r + sv[bj][n];
                bf16_t* dp = ob + (size_t)row * 1024;
                if (isu) { st4u(dp, pack8(v[0][0] * v[1][0], v[0][1] * v[1][1])); }
                else { st4u(dp, pack8(v[0][0], v[0][1])); st4u(dp + 128, pack8(v[1][0], v[1][1])); }
            }
    }
};


struct StaticOrderPF : StaticOrder {
    const float* pbase; PG8_LAS unsigned char* dummy; int ptid;
    __device__ __forceinline__ void a_ready(const Unit& u) const {
#ifdef NO_PF
        return;
#endif
        const char* p = (const char*)pbase + ((size_t)(u.pm * 256) * 1024 + u.pn * 256) * 4;
#pragma unroll
        for (int i = 0; i < 4; ++i) { const int line = ptid + 512 * i;
            __builtin_amdgcn_global_load_lds((const unsigned*)(p + (size_t)(line >> 3) * 4096 + (line & 7) * 128), (PG8_LAS unsigned*)dummy, 4, 0, 0); }
    }
};
template <class Epi, class Sched, bool ALIGN_EPI = false, bool SP2 = false>
__device__ __forceinline__ void gemm_phase(PG8_LAS unsigned char* lds, const Gemm g, const Sched& S, const Epi& E, const int tid_in) {
    const int tid = tid_in, wid = __builtin_amdgcn_readfirstlane(tid >> 6), lane = tid & 63, wr = wid >> 2, wc = wid & 3, fr = lane & 15, fq = lane >> 4;
    const int K = g.K, nt = K / BK;
    unsigned voffA[2], voffB[2];
#pragma unroll
    for (int i = 0; i < 2; ++i) { int R, C; stage_rc(tid * 16 + i * 8192, R, C); const int Rb = Epi::PERM ? ((R & ~31) + perm32(R & 31)) : R;
        voffA[i] = (unsigned)(R * K + C) * 2u; voffB[i] = (unsigned)(Rb * K + C) * 2u; }
    const size_t kstep = (size_t)(BK * 2);
    const size_t hstep = (size_t)HALF * K * 2;
    const size_t tstep = 2 * hstep;
    const unsigned ldsw = (unsigned)wid * 1024u;
    const int aoff = lds_byte(wr * 64 + fr, fq * 8), boff = lds_byte(wc * 32 + fr, fq * 8);
#define PG8_SA(b, h) (((b) * 2 + (h)) * HTB)
#define PG8_SB(b, h) ((4 + (b) * 2 + (h)) * HTB)
#define PG8_STAGE(bufoff, gbase, voff) do { _Pragma("unroll") for (int _i = 0; _i < 2; ++_i) \
        __builtin_amdgcn_global_load_lds((const unsigned*)((const char*)(gbase) + (voff)[_i]), (PG8_LAS unsigned*)(lds + (bufoff) + ldsw + _i * 8192), 16, 0, 0); } while (0)
#define PG8_LDA(dst, b, h) do { _Pragma("unroll") for (int m = 0; m < 4; ++m) _Pragma("unroll") for (int k = 0; k < 2; ++k) dst[m][k] = *(const PG8_LAS bf16x8*)(lds + PG8_SA(b, h) + aoff + m * 2048 + k * 1024); } while (0)
#define PG8_LDB(dst, b, h) do { _Pragma("unroll") for (int n = 0; n < 2; ++n) _Pragma("unroll") for (int k = 0; k < 2; ++k) dst[n][k] = *(const PG8_LAS bf16x8*)(lds + PG8_SB(b, h) + boff + n * 2048 + k * 1024); } while (0)
#define PG8_MMA(ai, bj, At, Bt) do { __builtin_amdgcn_s_setprio(1); _Pragma("unroll") for (int m = 0; m < 4; ++m) _Pragma("unroll") for (int n = 0; n < 2; ++n) _Pragma("unroll") for (int k = 0; k < 2; ++k) \
        acc[ai][bj][m][n] = __builtin_amdgcn_mfma_f32_16x16x32_bf16(Bt[n][k], At[m][k], acc[ai][bj][m][n], 0, 0, 0); __builtin_amdgcn_s_setprio(0); } while (0)
#define PG8_WAIT_V(n) asm volatile("s_waitcnt vmcnt(" #n ")" ::: "memory")
#define PG8_WAIT_L(n) asm volatile("s_waitcnt lgkmcnt(" #n ")" ::: "memory")
#define PG8_BAR __builtin_amdgcn_s_barrier()
#define PG8_SCHED __builtin_amdgcn_sched_barrier(0)
    Unit cur, nxt; int ui = 0;
    if (!S.next(0, cur)) return;
    f32x4 acc[2][2][4][2];
#pragma unroll
    for (int a = 0; a < 2; ++a)
#pragma unroll
        for (int b = 0; b < 2; ++b)
#pragma unroll
            for (int m = 0; m < 4; ++m)
#pragma unroll
                for (int n = 0; n < 2; ++n) acc[a][b][m][n] = (f32x4){0.f, 0.f, 0.f, 0.f};
    bf16x8 At[4][2], B0[2][2], B1[2][2];
    const char* cA = (const char*)g.A + (size_t)cur.pm * tstep; const char* cB = (const char*)g.Bt + (size_t)cur.pn * tstep;
    S.a_ready(cur);
    if constexpr (SP2) {
        PG8_STAGE(PG8_SB(0, 0), cB, voffB); PG8_STAGE(PG8_SB(0, 1), cB + hstep, voffB); PG8_STAGE(PG8_SA(0, 0), cA, voffA); PG8_STAGE(PG8_SA(0, 1), cA + hstep, voffA);
        if (wr == 1) PG8_BAR;
        PG8_WAIT_V(2); PG8_BAR;
        PG8_STAGE(PG8_SB(1, 0), cB + kstep, voffB); PG8_STAGE(PG8_SA(1, 0), cA + kstep, voffA); PG8_STAGE(PG8_SB(1, 1), cB + hstep + kstep, voffB);
        PG8_WAIT_V(6); PG8_BAR;
    } else {
        PG8_STAGE(PG8_SB(0, 0), cB, voffB); PG8_STAGE(PG8_SA(0, 0), cA, voffA); PG8_STAGE(PG8_SB(0, 1), cB + hstep, voffB); PG8_STAGE(PG8_SA(0, 1), cA + hstep, voffA);
        if (wr == 1) PG8_BAR;
        PG8_WAIT_V(4); PG8_BAR;
        PG8_STAGE(PG8_SB(1, 0), cB + kstep, voffB); PG8_STAGE(PG8_SA(1, 0), cA + kstep, voffA); PG8_STAGE(PG8_SB(1, 1), cB + hstep + kstep, voffB);
        PG8_WAIT_V(6); PG8_BAR;
    }
    for (;;) {
        const bool has_next = S.next(ui + 1, nxt);
        const char* nA = has_next ? (const char*)g.A + (size_t)nxt.pm * tstep : cA; const char* nB = has_next ? (const char*)g.Bt + (size_t)nxt.pn * tstep : cB;
        for (int t = 0; t < nt; t += 2) {
            const bool last = (t == nt - 2);
            const char* a1 = cA + (size_t)(t + 1) * kstep;
            const char* a2 = last ? nA : cA + (size_t)(t + 2) * kstep; const char* b2 = last ? nB : cB + (size_t)(t + 2) * kstep;
            const char* a3 = a2 + kstep; const char* b3 = b2 + kstep;
            if (last && has_next) S.a_ready(nxt);
            if constexpr (SP2) {
            PG8_LDB(B0, 0, 0); PG8_LDB(B1, 0, 1); PG8_SCHED; PG8_LDA(At, 0, 0); PG8_STAGE(PG8_SA(1, 1), a1 + hstep, voffA);
            PG8_WAIT_V(8); PG8_WAIT_L(0); PG8_BAR; PG8_MMA(0, 0, At, B0); PG8_MMA(0, 1, At, B1); PG8_BAR; PG8_SCHED;
            PG8_LDA(At, 0, 1); PG8_STAGE(PG8_SB(0, 0), b2, voffB); PG8_STAGE(PG8_SB(0, 1), b2 + hstep, voffB); PG8_STAGE(PG8_SA(0, 0), a2, voffA);
            PG8_WAIT_V(8); PG8_WAIT_L(0); PG8_BAR; PG8_MMA(1, 0, At, B0); PG8_MMA(1, 1, At, B1); PG8_BAR; PG8_SCHED;
            PG8_LDB(B0, 1, 0); PG8_LDB(B1, 1, 1); PG8_SCHED; PG8_LDA(At, 1, 0); PG8_STAGE(PG8_SA(0, 1), a2 + hstep, voffA);
            PG8_WAIT_V(8); PG8_WAIT_L(0); PG8_BAR; PG8_MMA(0, 0, At, B0); PG8_MMA(0, 1, At, B1); PG8_BAR; PG8_SCHED;
            PG8_LDA(At, 1, 1); PG8_STAGE(PG8_SB(1, 0), b3, voffB); PG8_STAGE(PG8_SB(1, 1), b3 + hstep, voffB); PG8_STAGE(PG8_SA(1, 0), a3, voffA);
            PG8_WAIT_V(8); PG8_WAIT_L(0); PG8_BAR; PG8_MMA(1, 0, At, B0); PG8_MMA(1, 1, At, B1); PG8_BAR; PG8_SCHED;
            } else {
            PG8_LDB(B0, 0, 0); PG8_SCHED; PG8_LDA(At, 0, 0); PG8_STAGE(PG8_SA(1, 1), a1 + hstep, voffA);
            PG8_WAIT_L(8); PG8_BAR; PG8_WAIT_L(0); PG8_MMA(0, 0, At, B0); PG8_BAR; PG8_SCHED;
            PG8_LDB(B1, 0, 1); PG8_STAGE(PG8_SB(0, 0), b2, voffB);
            PG8_BAR; PG8_WAIT_L(0); PG8_MMA(0, 1, At, B1); PG8_BAR;
            PG8_LDA(At, 0, 1); PG8_STAGE(PG8_SA(0, 0), a2, voffA);
            PG8_BAR; PG8_WAIT_L(0); PG8_MMA(1, 0, At, B0); PG8_BAR; PG8_SCHED;
            PG8_STAGE(PG8_SB(0, 1), b2 + hstep, voffB);
            PG8_WAIT_V(6); PG8_BAR; PG8_MMA(1, 1, At, B1); PG8_BAR;
            PG8_LDB(B0, 1, 0); PG8_SCHED; PG8_LDA(At, 1, 0); PG8_STAGE(PG8_SA(0, 1), a2 + hstep, voffA);
            PG8_WAIT_L(8); PG8_BAR; PG8_WAIT_L(0); PG8_MMA(0, 0, At, B0); PG8_BAR; PG8_SCHED;
            PG8_LDB(B1, 1, 1); PG8_STAGE(PG8_SB(1, 0), b3, voffB);
            PG8_BAR; PG8_WAIT_L(0); PG8_MMA(0, 1, At, B1); PG8_BAR;
            PG8_LDA(At, 1, 1); PG8_STAGE(PG8_SA(1, 0), a3, voffA);
            PG8_BAR; PG8_WAIT_L(0); PG8_MMA(1, 0, At, B0); PG8_BAR; PG8_SCHED;
            PG8_STAGE(PG8_SB(1, 1), b3 + hstep, voffB);
            PG8_WAIT_V(6); PG8_BAR; PG8_MMA(1, 1, At, B1); PG8_BAR;
            }
        }
        if constexpr (ALIGN_EPI) { if (wr == 0) PG8_BAR; }
        if constexpr (!Epi::AFTER_DRAIN) { E(acc, cur, wr, wc, fr, fq); S.done(cur); }
        if (!has_next) break;
#pragma unroll
        for (int a = 0; a < 2; ++a)
#pragma unroll
            for (int b = 0; b < 2; ++b)
#pragma unroll
                for (int m = 0; m < 4; ++m)
#pragma unroll
                    for (int n = 0; n < 2; ++n) acc[a][b][m][n] = (f32x4){0.f, 0.f, 0.f, 0.f};
        cur = nxt; cA = nA; cB = nB; ++ui;
        if constexpr (ALIGN_EPI) { if (wr == 1) PG8_BAR; }
    }
    PG8_WAIT_V(0);
    if constexpr (!ALIGN_EPI) { if (wr == 0) PG8_BAR; }
    PG8_BAR;
    if constexpr (Epi::AFTER_DRAIN) { E.fused(acc, cur, wr, wc, fr, fq, lds, wid, lane); S.done(cur); }
#undef PG8_SA
#undef PG8_SB
#undef PG8_STAGE
#undef PG8_LDA
#undef PG8_LDB
#undef PG8_MMA
#undef PG8_WAIT_V
#undef PG8_WAIT_L
#undef PG8_BAR
#undef PG8_SCHED
}
}

#define LAS __attribute__((address_space(3)))
typedef pg8::bf16_t bf16_t;
typedef short bf16x8 __attribute__((ext_vector_type(8)));
typedef short s16x4 __attribute__((ext_vector_type(4)));
typedef float f32x4 __attribute__((ext_vector_type(4)));
typedef float f32x16 __attribute__((ext_vector_type(16)));
typedef unsigned u32x4 __attribute__((ext_vector_type(4)));
typedef unsigned u32x2 __attribute__((ext_vector_type(2)));

constexpr int DM = 1024, NBATCH = 16, SEQ = 2048, MROWS = NBATCH * SEQ, DFF = 2816, NUP = 2 * DFF, NQKV = 1536, NCIN = 3072, NADA = 9 * DM, DEPTH = 4;
constexpr int NWAVES = 8, NTHREADS = NWAVES * 64;
constexpr int LDS_BYTES = 131072 + 1024 + 4096;
constexpr size_t MiB = 1u << 20;
constexpr size_t WS_UP = 0, WS_DN = 88 * MiB, WS_QKV = 132 * MiB, WS_O = 138 * MiB, WS_CIN = 142 * MiB, WS_COUT = 154 * MiB;
constexpr size_t WS_MOD = 158 * MiB, WS_SB = 161 * MiB, WS_RS = 166 * MiB, WS_COS = 168 * MiB, WS_SIN = 172 * MiB, WS_GT = 176 * MiB, WS_GATE = 177 * MiB, WS_AP = 178 * MiB, WS_BIG = 242 * MiB, WS_XALT = 434 * MiB, WS_END = 562 * MiB;
constexpr size_t WS_PAR = 177 * MiB + 768 * 1024;
constexpr int PAR_BO = 0, PAR_QG = 2048, PAR_KG = 2176, PAR_SINK = 2304, PAR_CW = 2336, PAR_N = 2336 + 6144;
constexpr size_t WS_BARW = WS_PAR + 64 * 1024;
constexpr size_t SB_STRIDE = (size_t)16 * NUP;
constexpr int NPH = 2 + 7 * DEPTH;

struct Args { const void* in[18]; float* out; unsigned char* ws; int ph_lo, ph_hi; };

__device__ const float INVF[32] = {1.0f, 0.7498942613601685f, 0.5623413324356079f, 0.4216965138912201f, 0.3162277638912201f, 0.23713737726211548f, 0.17782793939113617f, 0.133352130651474f,
    0.10000000149011612f, 0.07498941570520401f, 0.05623413249850273f, 0.04216965287923813f, 0.03162277489900589f, 0.023713737726211548f, 0.017782794311642647f, 0.01333521492779255f,
    0.009999999776482582f, 0.007498941849917173f, 0.005623413249850273f, 0.0042169648222625256f, 0.003162277629598975f, 0.00237137358635664f, 0.0017782794311642647f, 0.0013335214462131262f,
    0.0010000000474974513f, 0.0007498942431993783f, 0.000562341301701963f, 0.0004216965171508491f, 0.0003162277571391314f, 0.00023713737027719617f, 0.00017782794020604342f, 0.0001333521504420787f};

#define LDS_WAIT() asm volatile("s_waitcnt lgkmcnt(0)" ::: "memory")
__device__ __forceinline__ unsigned f2bf(float f) { unsigned u = __builtin_bit_cast(unsigned, f); return (u + 0x7fffu + ((u >> 16) & 1u)) >> 16; }
__device__ __forceinline__ unsigned pk2(float lo, float hi) { return f2bf(lo) | (f2bf(hi) << 16); }
__device__ __forceinline__ float bf_lo(unsigned w) { return __builtin_bit_cast(float, w << 16); }
__device__ __forceinline__ float bf_hi(unsigned w) { return __builtin_bit_cast(float, w & 0xffff0000u); }
__device__ __forceinline__ float wave_sum(float v) {
#pragma unroll
    for (int o = 1; o < 64; o <<= 1) v += __shfl_xor(v, o);
    return v;
}

#define RLX_AGENT __ATOMIC_RELAXED, __HIP_MEMORY_SCOPE_AGENT
#define XB_TMO      128
#define XB_XCNT(j)  (256  + 64 * (j))
#define XB_XSUB(j)  (1280 + 64 * (j))
#define XB_XGEN(j)  (2304 + 64 * (j))
#define XB_TOP      3328
#define XB_TOPGEN   3392
#define XCD_BAR_WORDS 3456
#define XB_SPIN_CAP (1u << 18)

__device__ __forceinline__ unsigned xb_ld(unsigned* p)              { return __hip_atomic_load(p, __ATOMIC_RELAXED, __HIP_MEMORY_SCOPE_AGENT); }
__device__ __forceinline__ unsigned xb_add(unsigned* p, unsigned v) { return __hip_atomic_fetch_add(p, v, __ATOMIC_RELAXED, __HIP_MEMORY_SCOPE_AGENT); }
__device__ __forceinline__ unsigned xb_xcc_id() { return (unsigned)__builtin_amdgcn_s_getreg((3 << 11) | 20) & 0xFu; }
#define XB_SPIN(cond, bar) do { unsigned _sp = 0; while (cond) { __builtin_amdgcn_s_sleep(1); \
    if ((++_sp & 255u) == 0u) { if (xb_ld(&(bar)[XB_TMO])) break; if (_sp > XB_SPIN_CAP) { atomicAdd(&(bar)[XB_TMO], 1u); break; } } } } while (0)

struct XcdBarrier {
    unsigned* bar; unsigned x;
    volatile LAS unsigned* st;
};

__device__ __forceinline__ XcdBarrier xcd_barrier_post(unsigned* bar, volatile LAS unsigned* st) {
    XcdBarrier b; b.bar = bar; b.x = xb_xcc_id(); b.st = st;
    if (threadIdx.x == 0) (void)xb_add(&bar[XB_XCNT(b.x)], 1u);
    return b;
}
__device__ __forceinline__ void xcd_barrier_complete(unsigned* bar, unsigned x, unsigned& nloc, unsigned& nx) {
    const unsigned G = gridDim.x * gridDim.y * gridDim.z;
    unsigned sum, cnt, mine, sp = 0u;
    for (;;) {
        sum = 0u; cnt = 0u; mine = 0u;
#pragma unroll
        for (unsigned j = 0; j < 16; ++j) { const unsigned c = xb_ld(&bar[XB_XCNT(j)]); sum += c; cnt += (c > 0u) ? 1u : 0u; mine = (j == x) ? c : mine; }
        if (sum == G) break;
        __builtin_amdgcn_s_sleep(1);
        if ((++sp & 255u) == 0u) { if (xb_ld(&bar[XB_TMO])) break; if (sp > XB_SPIN_CAP) { atomicAdd(&bar[XB_TMO], 1u); break; } }
    }
    nloc = mine > 0u ? mine : 1u; nx = cnt > 0u ? cnt : 1u;
}

__device__ __forceinline__ void xcd_barrier(const XcdBarrier& b) {
    asm volatile("s_waitcnt vmcnt(0)" ::: "memory");
    __syncthreads();
    if (threadIdx.x == 0) {
        unsigned* bar = b.bar;
        __builtin_amdgcn_s_waitcnt(0);
        unsigned nloc = b.st[0], nx = b.st[1];
        if (nloc == 0u) { xcd_barrier_complete(bar, b.x, nloc, nx); b.st[0] = nloc; b.st[1] = nx; }
        const unsigned old = xb_add(&bar[XB_XSUB(b.x)], 1u);
        const unsigned gen = old / nloc;
        if (old + 1u == (gen + 1u) * nloc) {
            __builtin_amdgcn_fence(__ATOMIC_RELEASE, "agent");
            asm volatile("s_waitcnt vmcnt(0)" ::: "memory");
            const unsigned og = xb_add(&bar[XB_TOP], 1u);
            const unsigned tg = og / nx;
            if (og + 1u == (tg + 1u) * nx) xb_add(&bar[XB_TOPGEN], 1u);
            else XB_SPIN(xb_ld(&bar[XB_TOPGEN]) == tg, bar);
            __builtin_amdgcn_fence(__ATOMIC_ACQUIRE, "agent");
            xb_add(&bar[XB_XGEN(b.x)], 1u);
            asm volatile("s_waitcnt vmcnt(0)" ::: "memory");
        } else {
            XB_SPIN(xb_ld(&bar[XB_XGEN(b.x)]) == gen, bar);
            __builtin_amdgcn_fence(__ATOMIC_ACQUIRE, "agent");
            asm volatile("s_waitcnt vmcnt(0)" ::: "memory");
        }
    }
    __syncthreads();
}

__device__ __forceinline__ int srcblk(int mode, int nb) {
    const int pn = nb >> 3, q = nb & 7;
    if (mode == 0) return nb;
    if (mode == 1) return (q >> 2) * 88 + 4 * pn + (q & 3);
    if (mode == 2) return 8 * pn + 2 * (q & 3) + (q >> 2);
    return pn < 8 ? 32 * (1 + (q >> 2)) + 4 * pn + (q & 3) : 8 * (pn - 8) + q;
}
__device__ __forceinline__ void transpose_item(const float* W, int K, int N, bf16_t* WT, int mode, LAS float* scr, int item, int lane) {
    const int nblk = N / 32, kb = item / nblk, nb = item % nblk, k0 = 64 * kb, n0 = 32 * nb, s0 = 32 * srcblk(mode, nb);
    float wv[32];
    const float* wsrc = W + (size_t)(k0 + (lane >> 5)) * N + s0 + (lane & 31);
#pragma unroll
    for (int i = 0; i < 32; ++i) wv[i] = wsrc[(size_t)(2 * i) * N];
#pragma unroll
    for (int i = 0; i < 32; ++i) scr[(2 * i + (lane >> 5)) * 33 + (lane & 31)] = wv[i];
    LDS_WAIT(); asm volatile("" ::: "memory");
    const int c = lane & 7;
#pragma unroll
    for (int j = 0; j < 4; ++j) { const int n = (lane >> 3) + 8 * j; const LAS float* s = scr + (8 * c) * 33 + n;
        u32x4 o; o.x = pk2(s[0 * 33], s[1 * 33]); o.y = pk2(s[2 * 33], s[3 * 33]); o.z = pk2(s[4 * 33], s[5 * 33]); o.w = pk2(s[6 * 33], s[7 * 33]);
        *(u32x4*)(WT + (size_t)(n0 + n) * K + k0 + 8 * c) = o; }
    LDS_WAIT(); asm volatile("" ::: "memory");
}
constexpr int IT_UP = 8 * 2816, IT_DN = 8 * 1408, IT_QKV = 2 * 768, IT_O = 2 * 512, IT_CIN = 2 * 1536, IT_COUT = 2 * 512;
constexpr int NITEMS = IT_UP + IT_DN + IT_QKV + IT_O + IT_CIN + IT_COUT;
__device__ __forceinline__ void conv_item(const Args& a, int it, LAS float* scr, int lane) {
    unsigned char* ws = a.ws; int r = it;
    if (r < IT_UP) { const int i = r / 2816; r -= i * 2816; transpose_item((const float*)a.in[6] + (size_t)i * 1024 * NUP, 1024, NUP, (bf16_t*)(ws + WS_UP) + (size_t)i * NUP * 1024, 1, scr, r, lane); return; }
    r -= IT_UP;
    if (r < IT_DN) { const int i = r / 1408; r -= i * 1408; transpose_item((const float*)a.in[7] + (size_t)i * DFF * 1024, DFF, 1024, (bf16_t*)(ws + WS_DN) + (size_t)i * 1024 * DFF, 0, scr, r, lane); return; }
    r -= IT_DN;
    if (r < IT_QKV) { const int i = r / 768; r -= i * 768; transpose_item((const float*)a.in[8] + (size_t)i * 1024 * NQKV, 1024, NQKV, (bf16_t*)(ws + WS_QKV) + (size_t)i * NQKV * 1024, 2, scr, r, lane); return; }
    r -= IT_QKV;
    if (r < IT_O) { const int i = r / 512; r -= i * 512; transpose_item((const float*)a.in[13] + (size_t)i * 1024 * 1024, 1024, 1024, (bf16_t*)(ws + WS_O) + (size_t)i * 1024 * 1024, 0, scr, r, lane); return; }
    r -= IT_O;
    if (r < IT_CIN) { const int i = r / 1536; r -= i * 1536; transpose_item((const float*)a.in[15] + (size_t)i * 1024 * NCIN, 1024, NCIN, (bf16_t*)(ws + WS_CIN) + (size_t)i * NCIN * 1024, 3, scr, r, lane); return; }
    r -= IT_CIN;
    { const int i = r / 512; r -= i * 512; transpose_item((const float*)a.in[17] + (size_t)i * 1024 * 1024, 1024, 1024, (bf16_t*)(ws + WS_COUT) + (size_t)i * 1024 * 1024, 0, scr, r, lane); }
}

constexpr int GEMV_TASKS = DEPTH * (NADA / 256);
__device__ __forceinline__ void gemv_task(const Args& a, int task, LAS unsigned char* lds, int tid, int lane, int wid) {
    const float* c = (const float*)a.in[1]; const float* w_ada = (const float*)a.in[4]; const float* b_ada = (const float*)a.in[5];
    float* mod = (float*)(a.ws + WS_MOD);
    LAS float* cact = (LAS float*)lds;
    LAS float* red = (LAS float*)(lds + 65536);
    const int l = task / 36, n0 = (task % 36) * 256;
    __syncthreads();
    { int t0 = tid; asm volatile("" : "+v"(t0));
#pragma unroll 4
      for (int i = 0; i < 32; ++i) { const int idx = t0 + 512 * i, k = idx >> 4, b = idx & 15; const float v = c[b * 1024 + k]; cact[idx] = v / (1.f + __expf(-v)); } }
    __syncthreads();
    float acc[64];
#pragma unroll
    for (int i = 0; i < 64; ++i) acc[i] = 0.f;
    const float* wp = w_ada + ((size_t)l * 1024 + wid * 128) * NADA + n0 + 4 * lane;
#pragma unroll 1
    for (int kb = 0; kb < 128; kb += 8) {
        f32x4 wv[8];
#pragma unroll
        for (int u = 0; u < 8; ++u) wv[u] = *(const f32x4*)(wp + (size_t)(kb + u) * NADA);
#pragma unroll
        for (int u = 0; u < 8; ++u) {
            const LAS f32x4* cp = (const LAS f32x4*)(cact + (wid * 128 + kb + u) * 16);
#pragma unroll
            for (int bq = 0; bq < 4; ++bq) { const f32x4 cb = cp[bq];
#pragma unroll
                for (int e = 0; e < 4; ++e)
#pragma unroll
                    for (int j = 0; j < 4; ++j) acc[(bq * 4 + e) * 4 + j] += cb[e] * wv[u][j]; }
            asm volatile("" ::: "memory");
        }
    }
#pragma unroll
    for (int r = 0; r < 2; ++r) {
#pragma unroll
        for (int q = 0; q < 32; ++q) red[(wid * 32 + q) * 64 + lane] = acc[32 * r + q];
        __syncthreads();
#pragma unroll
        for (int i = 0; i < 4; ++i) { const int idx = tid + 512 * i, q = idx >> 6, ln = idx & 63; float s = 0.f;
#pragma unroll
            for (int w = 0; w < 8; ++w) s += red[(w * 32 + q) * 64 + ln];
            const int A = 32 * r + q, bb = A >> 2, j = A & 3;
            mod[((size_t)l * 16 + bb) * NADA + n0 + 4 * ln + j] = s + b_ada[l * NADA + n0 + 4 * ln + j]; }
        __syncthreads();
    }
}

__device__ __forceinline__ void sincos_acc(float angf, float& co, float& si) {
    const double a = (double)angf;
    const double qd = __builtin_rint(a * 0.63661977236758134308);
    const double r = __builtin_fma(-qd, 1.57079632679489661923, a), r2 = r * r;
    double sp = 1.0 / 6227020800.0; sp = sp * r2 - 1.0 / 39916800.0; sp = sp * r2 + 1.0 / 362880.0; sp = sp * r2 - 1.0 / 5040.0; sp = sp * r2 + 1.0 / 120.0; sp = sp * r2 - 1.0 / 6.0; sp = sp * r2 + 1.0; sp = sp * r;
    double cp = 1.0 / 479001600.0; cp = cp * r2 - 1.0 / 3628800.0; cp = cp * r2 + 1.0 / 40320.0; cp = cp * r2 - 1.0 / 720.0; cp = cp * r2 + 1.0 / 24.0; cp = cp * r2 - 0.5; cp = cp * r2 + 1.0;
    const int q = ((int)qd) & 3;
    const double s = (q == 0) ? sp : (q == 1) ? cp : (q == 2) ? -sp : -cp;
    const double cc = (q == 0) ? cp : (q == 1) ? -sp : (q == 2) ? -cp : sp;
    co = (float)cc; si = (float)s;
}

__device__ __forceinline__ void p0a(const Args& a, LAS unsigned char* lds, int tid, int lane, int wid) {
    const int G = gridDim.x, bx = blockIdx.x;
    int ngemv = G < GEMV_TASKS ? G : GEMV_TASKS;
    constexpr int XSPLIT = 3840;
    if (bx < ngemv) { for (int t = bx; t < GEMV_TASKS; t += ngemv) gemv_task(a, t, lds, tid, lane, wid); __syncthreads(); }
    LAS float* scr = (LAS float*)(lds + wid * 16384);
    int xs = 0;
    if (G > ngemv) { xs = XSPLIT; if (bx >= ngemv) { const int nw = (G - ngemv) * NWAVES; for (int it = (bx - ngemv) * NWAVES + wid; it < xs; it += nw) conv_item(a, it, scr, lane); } }
    { const int nw = G * NWAVES; for (int it = xs + bx * NWAVES + wid; it < NITEMS; it += nw) conv_item(a, it, scr, lane); }
    if (bx == 0) { unsigned* bw = (unsigned*)(a.ws + WS_BARW); for (int i = tid; i < XCD_BAR_WORDS; i += NTHREADS) bw[i] = 0u; }
    const int gt = bx * NTHREADS + tid, nt = G * NTHREADS;
    const int* pos = (const int*)a.in[2]; float* cosT = (float*)(a.ws + WS_COS); float* sinT = (float*)(a.ws + WS_SIN);
    for (int idx = gt; idx < MROWS * 32; idx += nt) { const int row = idx >> 5, p = idx & 31; const float ang = (float)pos[row] * INVF[p]; float co, si; sincos_acc(ang, co, si); cosT[idx] = co; sinT[idx] = si; }
}

__device__ __forceinline__ float gclamp(float g) { return fabsf(g) < 1e-20f ? copysignf(1e-20f, g) : g; }
constexpr int SB_TASKS = (8 * NUP + 2 * NQKV + 2 * NCIN) / 16;
__device__ __forceinline__ void sb_task(const Args& a, int task, int lane) {
    int s = 0, r = task, N = NUP;
    for (s = 0; s < 12; ++s) { const int l = s / 3, j = s % 3; N = (j != 1) ? NUP : ((l & 1) ? NCIN : NQKV); if (r < N / 16) break; r -= N / 16; }
    const int l = s / 3, j = s % 3;
    const bf16_t* Bt;
    if (j == 0) Bt = (const bf16_t*)(a.ws + WS_UP) + (size_t)(2 * l) * NUP * 1024;
    else if (j == 2) Bt = (const bf16_t*)(a.ws + WS_UP) + (size_t)(2 * l + 1) * NUP * 1024;
    else if (l & 1) Bt = (const bf16_t*)(a.ws + WS_CIN) + (size_t)(l >> 1) * NCIN * 1024;
    else Bt = (const bf16_t*)(a.ws + WS_QKV) + (size_t)(l >> 1) * NQKV * 1024;
    const float* shift = (const float*)(a.ws + WS_MOD) + (size_t)l * 16 * NADA + 3 * j * 1024;
    float* sb = (float*)(a.ws + WS_SB) + (size_t)s * SB_STRIDE;
    const int n0 = 16 * r, i16 = lane & 15, kq = lane >> 4;
    const bf16_t* bp = Bt + (size_t)(n0 + i16) * 1024 + 8 * kq;
    const float* sp = shift + (size_t)i16 * NADA + 8 * kq;
    f32x4 c = {0.f, 0.f, 0.f, 0.f};
#pragma unroll 8
    for (int kk = 0; kk < 32; ++kk) {
        const bf16x8 wb = *(const bf16x8*)(bp + 32 * kk);
        const f32x4 s0 = *(const f32x4*)(sp + 32 * kk), s1 = *(const f32x4*)(sp + 32 * kk + 4);
        u32x4 w; w.x = pk2(s0[0], s0[1]); w.y = pk2(s0[2], s0[3]); w.z = pk2(s1[0], s1[1]); w.w = pk2(s1[2], s1[3]);
        c = __builtin_amdgcn_mfma_f32_16x16x32_bf16(wb, __builtin_bit_cast(bf16x8, w), c, 0, 0, 0);
    }
    const int n = n0 + 4 * kq;
    if (j == 1 && !(l & 1)) { const int pn = n >> 8, q = (n >> 5) & 7, src = 256 * pn + 64 * (q & 3) + 32 * (q >> 2) + (n & 31);
        const f32x4 bv = *(const f32x4*)((const float*)a.in[9] + (size_t)(l >> 1) * NQKV + src); c = c + bv; }
    *(f32x4*)(sb + (size_t)i16 * N + n) = c;
}
__device__ __forceinline__ void p0b(const Args& a, int tid, int lane, int wid) {
    const int gw = blockIdx.x * NWAVES + wid, NGW = gridDim.x * NWAVES;
    for (int t = gw; t < SB_TASKS; t += NGW) sb_task(a, t, lane);
    const float* x = (const float*)a.in[0]; const float* gain = (const float*)a.in[3]; const float* mod = (const float*)(a.ws + WS_MOD);
    { float* par = (float*)(a.ws + WS_PAR);
      for (int idx = blockIdx.x * NTHREADS + tid; idx < PAR_N; idx += gridDim.x * NTHREADS) { float v;
          if (idx < PAR_QG) v = ((const float*)a.in[14])[idx]; else if (idx < PAR_KG) v = ((const float*)a.in[10])[idx - PAR_QG]; else if (idx < PAR_SINK) v = ((const float*)a.in[11])[idx - PAR_KG];
          else if (idx < PAR_CW) v = ((const float*)a.in[12])[idx - PAR_SINK]; else v = ((const float*)a.in[16])[idx - PAR_CW];
          par[idx] = v; } }
    { float* GT = (float*)(a.ws + WS_GT); float* GATE = (float*)(a.ws + WS_GATE);
      for (int idx = blockIdx.x * NTHREADS + tid; idx < 12 * 16 * 1024; idx += gridDim.x * NTHREADS) { const int s = idx >> 14, b = (idx >> 10) & 15, k = idx & 1023, l = s / 3, j = s % 3;
          const float* m = mod + ((size_t)l * 16 + b) * NADA + 3 * j * 1024; { const float g_ = gclamp(gain[s * 1024 + k] * (1.0f + m[1024 + k])); GT[idx] = g_; ((float*)(a.ws + WS_XALT))[idx] = 1.0f / g_; } GATE[idx] = (j == 1 ? 1.0f : 0.5f) * m[2048 + k]; } }
    bf16_t* AP = (bf16_t*)(a.ws + WS_AP); float* rs = (float*)(a.ws + WS_RS);
    for (int row0 = gw; row0 < MROWS; row0 += 4 * NGW) {
        f32x4 v[4][4];
#pragma unroll
        for (int q = 0; q < 4; ++q) { const int row = row0 + q * NGW; if (row < MROWS) { const float* xr = x + (size_t)row * 1024 + 4 * lane;
#pragma unroll
                for (int j = 0; j < 4; ++j) v[q][j] = *(const f32x4*)(xr + 256 * j); } }
#pragma unroll
        for (int q = 0; q < 4; ++q) { const int row = row0 + q * NGW; if (row < MROWS) {
            const int b = row >> 11; const float* sc = mod + (size_t)b * NADA + 1024 + 4 * lane; float ss = 0.f;
#pragma unroll
            for (int j = 0; j < 4; ++j) ss += (v[q][j][0] * v[q][j][0] + v[q][j][1] * v[q][j][1]) + (v[q][j][2] * v[q][j][2] + v[q][j][3] * v[q][j][3]);
            ss = wave_sum(ss);
            if (lane < 4) *(f32x4*)(rs + (size_t)row * 16 + 4 * lane) = (f32x4){lane == 0 ? ss : 0.f, 0.f, 0.f, 0.f};
#pragma unroll
            for (int j = 0; j < 4; ++j) { f32x4 g = *(const f32x4*)(gain + 4 * lane + 256 * j) * (*(const f32x4*)(sc + 256 * j) + 1.0f); g[0] = gclamp(g[0]); g[1] = gclamp(g[1]); g[2] = gclamp(g[2]); g[3] = gclamp(g[3]); const f32x4 o = v[q][j] * g;
                u32x2 w; w.x = pk2(o[0], o[1]); w.y = pk2(o[2], o[3]); *(u32x2*)(AP + (size_t)row * 1024 + 4 * lane + 256 * j) = w; } } }
    }
}

constexpr int ATT_KS = 144, ATT_VS = 260, ATT_VOFF = 256 * ATT_KS;
__device__ __forceinline__ void attn_phase(LAS unsigned char* lds, const bf16_t* Q, const bf16_t* K, const bf16_t* V, bf16_t* O, const float* sinks, int tid, int lane, int wid, int u_first, int u_end, int u_step) {
    const int q32 = lane & 31, hi = lane >> 5;
    const float NEG = -__builtin_inff();
    for (int unit = u_first; unit < u_end; unit += u_step) {
        const int qb = unit & 15, kvh = (unit >> 4) & 3, b = unit >> 6;
        const size_t rowbase = (size_t)b * SEQ; const int kstart = (qb - 1) * 128;
        __syncthreads();
#pragma unroll
        for (int i = 0; i < 4; ++i) { const int idx = tid + 512 * i, row = idx >> 3, ch = idx & 7, kr = kstart + row;
            u32x4 kv = {0u, 0u, 0u, 0u}, vv = {0u, 0u, 0u, 0u};
            if (kr >= 0) { kv = *(const u32x4*)(K + (rowbase + kr) * 256 + kvh * 64 + ch * 8); vv = *(const u32x4*)(V + (rowbase + kr) * 256 + kvh * 64 + ch * 8); }
            *(LAS u32x4*)(lds + row * ATT_KS + ch * 16) = kv;
            LAS bf16_t* vt = (LAS bf16_t*)(lds + ATT_VOFF) + (ch * 8) * ATT_VS + row;
#pragma unroll
            for (int e = 0; e < 8; ++e) vt[e * ATT_VS] = (bf16_t)((vv[e >> 1] >> (16 * (e & 1))) & 0xffffu);
        }
        __syncthreads();
        const int head = kvh * 4 + (wid >> 1), h2 = wid & 1;
        const float sink2 = sinks[head] * 1.44269504f;
#pragma unroll 1
        for (int qi = 0; qi < 2; ++qi) {
            const int qo = 64 * h2 + 32 * qi, kt0 = qo >> 5;
            const size_t qrow = rowbase + qb * 128 + qo + q32;
            bf16x8 qr[4];
#pragma unroll
            for (int ks = 0; ks < 4; ++ks) qr[ks] = *(const bf16x8*)(Q + qrow * 1024 + head * 64 + ks * 16 + hi * 8);
            f32x16 s[5];
#pragma unroll
            for (int j = 0; j < 5; ++j) {
                const int kt = kt0 + j;
                f32x16 acc = {0.f, 0.f, 0.f, 0.f, 0.f, 0.f, 0.f, 0.f, 0.f, 0.f, 0.f, 0.f, 0.f, 0.f, 0.f, 0.f};
#pragma unroll
                for (int ks = 0; ks < 4; ++ks) { const bf16x8 ka = *(const LAS bf16x8*)(lds + (32 * kt + q32) * ATT_KS + ks * 32 + hi * 16);
                    acc = __builtin_amdgcn_mfma_f32_32x32x16_bf16(ka, qr[ks], acc, 0, 0, 0); }
                const bool dead = (qb == 0) && (kt < 4);
#pragma unroll
                for (int r = 0; r < 16; ++r) { const int key = (r & 3) + 8 * (r >> 2) + 4 * hi;
                    bool ok = !dead;
                    if (j == 0) ok = ok && (q32 < key);
                    if (j == 4) ok = ok && (key <= q32);
                    acc[r] = ok ? acc[r] : NEG; }
                s[j] = acc;
            }
            float mx = sink2;
#pragma unroll
            for (int j = 0; j < 5; ++j)
#pragma unroll
                for (int r = 0; r < 16; ++r) mx = fmaxf(mx, s[j][r]);
            mx = fmaxf(mx, __shfl_xor(mx, 32));
            float l = 0.f;
#pragma unroll
            for (int j = 0; j < 5; ++j)
#pragma unroll
                for (int r = 0; r < 16; ++r) { const float p = __builtin_amdgcn_exp2f(s[j][r] - mx); s[j][r] = p; l += p; }
            l += __shfl_xor(l, 32);
            l += __builtin_amdgcn_exp2f(sink2 - mx);
            f32x16 o[2];
#pragma unroll
            for (int db = 0; db < 2; ++db) o[db] = (f32x16){0.f, 0.f, 0.f, 0.f, 0.f, 0.f, 0.f, 0.f, 0.f, 0.f, 0.f, 0.f, 0.f, 0.f, 0.f, 0.f};
#pragma unroll
            for (int j = 0; j < 5; ++j) {
                const int kt = kt0 + j;
#pragma unroll
                for (int st = 0; st < 2; ++st) {
                    u32x4 pw; pw.x = pg8::cvt_pk_bf16(s[j][8 * st + 0], s[j][8 * st + 1]); pw.y = pg8::cvt_pk_bf16(s[j][8 * st + 2], s[j][8 * st + 3]);
                    pw.z = pg8::cvt_pk_bf16(s[j][8 * st + 4], s[j][8 * st + 5]); pw.w = pg8::cvt_pk_bf16(s[j][8 * st + 6], s[j][8 * st + 7]);
                    const bf16x8 pb = __builtin_bit_cast(bf16x8, pw);
#pragma unroll
                    for (int db = 0; db < 2; ++db) {
                        const LAS unsigned char* vp = lds + ATT_VOFF + ((q32 + 32 * db) * ATT_VS + 32 * kt + 16 * st + 4 * hi) * 2;
                        const s16x4 lo = *(const LAS s16x4*)(vp), hh = *(const LAS s16x4*)(vp + 16);
                        const bf16x8 va = {lo[0], lo[1], lo[2], lo[3], hh[0], hh[1], hh[2], hh[3]};
                        o[db] = __builtin_amdgcn_mfma_f32_32x32x16_bf16(va, pb, o[db], 0, 0, 0);
                    }
                }
            }
            const float inv = 1.0f / l;
            bf16_t* op = O + qrow * 1024 + head * 64 + 4 * hi;
#pragma unroll
            for (int db = 0; db < 2; ++db)
#pragma unroll
                for (int rq = 0; rq < 4; ++rq) { u32x2 w; w.x = pg8::cvt_pk_bf16(o[db][4 * rq] * inv, o[db][4 * rq + 1] * inv); w.y = pg8::cvt_pk_bf16(o[db][4 * rq + 2] * inv, o[db][4 * rq + 3] * inv);
                    *(u32x2*)(op + 32 * db + 8 * rq) = w; }
        }
    }
}

__device__ __forceinline__ void unpack8(u32x4 w, float (&f)[8]) {
#pragma unroll
    for (int i = 0; i < 4; ++i) { f[2 * i] = bf_lo(w[i]); f[2 * i + 1] = bf_hi(w[i]); }
}
__device__ __forceinline__ void conv_phase(const bf16_t* U, const bf16_t* GB, bf16_t* A2, const float* cw, int tid, int t_first, int t_end, int t_step) {
    const int c8 = (tid & 127) * 8, chunk = tid >> 7;
    float w0[8], w1[8], w2[8];
#pragma unroll
    for (int e = 0; e < 8; ++e) { w0[e] = cw[c8 + e]; w1[e] = cw[1024 + c8 + e]; w2[e] = cw[2048 + c8 + e]; }
    for (int task = t_first; task < t_end; task += t_step) {
        const int rstart = task * 64 + chunk * 16, t0 = rstart & (SEQ - 1);
        float um2[8], um1[8];
        if (t0 > 0) { unpack8(*(const u32x4*)(U + (size_t)(rstart - 2) * 1024 + c8), um2); unpack8(*(const u32x4*)(U + (size_t)(rstart - 1) * 1024 + c8), um1); }
        else {
#pragma unroll
            for (int e = 0; e < 8; ++e) { um2[e] = 0.f; um1[e] = 0.f; } }
#pragma unroll 4
        for (int i = 0; i < 16; ++i) {
            const size_t off = (size_t)(rstart + i) * 1024 + c8;
            float uc[8], g[8], y[8]; unpack8(*(const u32x4*)(U + off), uc); unpack8(*(const u32x4*)(GB + off), g);
#pragma unroll
            for (int e = 0; e < 8; ++e) { y[e] = g[e] * (w0[e] * um2[e] + w1[e] * um1[e] + w2[e] * uc[e]); um2[e] = um1[e]; um1[e] = uc[e]; }
            u32x4 w; w.x = pk2(y[0], y[1]); w.y = pk2(y[2], y[3]); w.z = pk2(y[4], y[5]); w.w = pk2(y[6], y[7]);
            *(u32x4*)(A2 + off) = w;
        }
    }
}

__device__ __forceinline__ void xcc_barrier(unsigned* bar, unsigned x, unsigned nloc) {
    asm volatile("s_waitcnt vmcnt(0)" ::: "memory");
    __syncthreads();
    if (threadIdx.x == 0) {
        __builtin_amdgcn_s_waitcnt(0);
        const unsigned old = xb_add(&bar[XB_XSUB(x)], 1u);
        const unsigned gen = old / nloc;
        if (old + 1u == (gen + 1u) * nloc) xb_add(&bar[XB_XGEN(x)], 1u);
        else XB_SPIN(xb_ld(&bar[XB_XGEN(x)]) == gen, bar);
        __builtin_amdgcn_fence(__ATOMIC_ACQUIRE, "agent");
        asm volatile("s_waitcnt vmcnt(0)" ::: "memory");
    }
    __syncthreads();
}

__device__ __forceinline__ void grid_seam() {
    asm volatile("s_waitcnt vmcnt(0) lgkmcnt(0)" ::: "memory");
    __syncthreads();
    cg::this_grid().sync();
    __builtin_amdgcn_fence(__ATOMIC_ACQUIRE, "agent");
    asm volatile("s_waitcnt vmcnt(0)" ::: "memory");
}
#ifndef MK_MULTI
#define MK_MULTI 0
#endif
#ifndef LAYER_STEPS
#define LAYER_STEPS {0, 1, 2, 3, 4, 5, 6}
#endif
__device__ const int LSTEP[] = LAYER_STEPS;
constexpr int NLS = sizeof(LSTEP) / sizeof(int);
#ifndef REP_PRO
#define REP_PRO 1
#endif
#ifndef REP_P0B
#define REP_P0B 1
#endif
__global__ void __launch_bounds__(NTHREADS, 2) mk_fwd(Args a) {
    extern __shared__ __attribute__((aligned(16))) unsigned char lds_raw[];
    LAS unsigned char* lds = (LAS unsigned char*)lds_raw;
    unsigned char* ws = a.ws;
    volatile LAS unsigned* bst = (volatile LAS unsigned*)(lds + 131072 + 512);
    if (threadIdx.x == 0) { bst[0] = 0u; bst[1] = 0u; }
    __syncthreads();
    {
        int tid = threadIdx.x; asm volatile("" : "+v"(tid)); const int lane = tid & 63, wid = __builtin_amdgcn_readfirstlane(tid >> 6);
#ifndef NO_P0A
        for (int rep = 0; rep < REP_PRO; ++rep) { p0a(a, lds, tid, lane, wid); __syncthreads(); }
#endif
        grid_seam();
    }
    if (threadIdx.x == 0) bst[2] = xb_add((unsigned*)(ws + WS_BARW) + XB_XCNT(xb_xcc_id()), 1u);
#define XBAR() do { XcdBarrier xb_; xb_.bar = (unsigned*)(ws + WS_BARW); xb_.x = xb_xcc_id(); xb_.st = bst; xcd_barrier(xb_); } while (0)
    {
        int tid = threadIdx.x; asm volatile("" : "+v"(tid)); const int lane = tid & 63, wid = __builtin_amdgcn_readfirstlane(tid >> 6);
#ifndef NO_P0B
        for (int rep = 0; rep < REP_P0B; ++rep) p0b(a, tid, lane, wid);
#endif
        XBAR();
    }
    if (threadIdx.x == 0) { unsigned* bw = (unsigned*)(ws + WS_BARW); bool reg = (gridDim.x == 256u);
        for (unsigned j = 0; j < 8; ++j) reg = reg && (xb_ld(&bw[XB_XCNT(j)]) == 32u);
#ifdef FORCE_GLOBAL
        reg = false;
#endif
        const unsigned x = xb_xcc_id();
        bst[3] = reg ? 1u : 0u; bst[4] = reg ? bst[2] * 8u + x : (unsigned)blockIdx.x; bst[5] = x; }
    __syncthreads();
    const float* xin = (const float*)a.in[0]; float* const outp = a.out;
    for (int it = 0; it < DEPTH * NLS; ++it) {
        unsigned char* ws = a.ws; asm volatile("" : "+s"(ws));
#define SLAB_EL ((size_t)12 * MiB)
#define TBASE(off_el, pitch, flat_el) (BST(3) ? BIG + (size_t)BST(5) * SLAB_EL + (size_t)(off_el) - (size_t)BST(5) * 4096 * (pitch) : BIG + (size_t)(flat_el))
#define T_ACT TBASE(0, DFF, 0)
#define T_Q   TBASE(0, 1024, 0)
#define T_K   TBASE(4 * MiB, 256, 32 * MiB)
#define T_V   TBASE(5 * MiB, 256, 40 * MiB)
#define T_ATT TBASE(6 * MiB, 1024, 48 * MiB)
#define T_U   TBASE(0, 1024, 0)
#define T_GB  TBASE(4 * MiB, 1024, (size_t)MROWS * 1024)
#define T_A2  TBASE(8 * MiB, 1024, (size_t)2 * MROWS * 1024)
#define BST(i) __builtin_amdgcn_readfirstlane((int)bst[i])
        float* rs = (float*)(ws + WS_RS); const float* sbt = (const float*)(ws + WS_SB);
        bf16_t* AP = (bf16_t*)(ws + WS_AP); bf16_t* BIG = (bf16_t*)(ws + WS_BIG);
        const float* GT = (const float*)(ws + WS_GT); const float* GATE = (const float*)(ws + WS_GATE);
        const float* par = (const float*)(ws + WS_PAR);
        int tid = threadIdx.x; asm volatile("" : "+v"(tid));
        const int lane = tid & 63, wid = __builtin_amdgcn_readfirstlane(tid >> 6);
        {
            const int l = it / NLS, k = LSTEP[it % NLS], s0 = 3 * l, jx = l >> 1;
            if (k == 0 || k == 5) {
                const int i = (k == 5), s = s0 + 2 * i;
                pg8::Gemm g{AP, (const bf16_t*)(ws + WS_UP) + (size_t)(2 * l + i) * NUP * 1024, MROWS, NUP, 1024};
                pg8::StaticOrder S; S.init(MROWS, NUP, gridDim.x, BST(4));
                pg8::EpiUp E{T_ACT, rs, sbt + (size_t)s * SB_STRIDE, (LAS float*)(lds + 131072 + 1024), -1};
                #ifndef NO_UP
                pg8::gemm_phase<pg8::EpiUp, pg8::StaticOrder, true, true>(lds, g, S, E, tid);
#endif
            } else if (k == 1 || k == 6 || k == 4) {
                pg8::Gemm g; pg8::EpiResid E;
                const int ridx = 3 * l + (k == 1 ? 0 : (k == 4 ? 1 : 2));
                E.out = (ridx == 3 * DEPTH - 1) ? outp : nullptr;
                E.AP_in = AP; E.RGp = (const float*)(ws + WS_XALT) + (size_t)ridx * 16384; E.AP = AP; E.bias = nullptr;
                if (k == 4) {
                    g = pg8::Gemm{(l & 1) ? T_A2 : T_ATT, (l & 1) ? (const bf16_t*)(ws + WS_COUT) + (size_t)jx * 1024 * 1024 : (const bf16_t*)(ws + WS_O) + (size_t)jx * 1024 * 1024, MROWS, 1024, 1024};
                    E.gate = GATE + (s0 + 1) * 16384; if (!(l & 1)) E.bias = par + PAR_BO + jx * 1024;
                    E.Gn = GT + (s0 + 2) * 16384; E.nrowss = rs;
                } else {
                    const int i = (k == 6);
                    g = pg8::Gemm{T_ACT, (const bf16_t*)(ws + WS_DN) + (size_t)(2 * l + i) * 1024 * DFF, MROWS, 1024, DFF};
                    E.gate = GATE + (s0 + 2 * i) * 16384;
                    if (!i) { E.Gn = GT + (s0 + 1) * 16384; E.nrowss = rs; }
                    else if (l < DEPTH - 1) { E.Gn = GT + (s0 + 3) * 16384; E.nrowss = rs; }
                    else { E.AP = nullptr; E.Gn = GT; E.nrowss = rs; }
                }
                pg8::StaticOrder S; S.init(MROWS, 1024, gridDim.x, BST(4));
                #ifndef NO_RES
                pg8::gemm_phase<pg8::EpiResid, pg8::StaticOrder, true, true>(lds, g, S, E, tid);
#endif
            } else if (k == 2) {
                if (!(l & 1)) {
                    pg8::Gemm g{AP, (const bf16_t*)(ws + WS_QKV) + (size_t)jx * NQKV * 1024, MROWS, NQKV, 1024};
                    pg8::StaticOrder S; S.init(MROWS, NQKV, gridDim.x, BST(4));
                    pg8::EpiQKV E{T_Q, T_K, T_V, rs, sbt + (size_t)(s0 + 1) * SB_STRIDE,
                                  par + PAR_QG + jx * 64, par + PAR_KG + jx * 64, (const float*)(ws + WS_COS), (const float*)(ws + WS_SIN)};
                    #ifndef NO_QKV
                    pg8::gemm_phase<pg8::EpiQKV, pg8::StaticOrder, true, true>(lds, g, S, E, tid);
#endif
                } else {
                    pg8::Gemm g{AP, (const bf16_t*)(ws + WS_CIN) + (size_t)jx * NCIN * 1024, MROWS, NCIN, 1024};
                    pg8::StaticOrder S; S.init(MROWS, NCIN, gridDim.x, BST(4));
                    pg8::EpiCin E{T_U, T_GB, rs, sbt + (size_t)(s0 + 1) * SB_STRIDE};
                    #ifndef NO_CIN
                    pg8::gemm_phase<pg8::EpiCin, pg8::StaticOrder, true, true>(lds, g, S, E, tid);
#endif
                }
            } else {
#ifndef NO_ATT
                if (!(l & 1)) attn_phase(lds, T_Q, T_K, T_V, T_ATT, par + PAR_SINK + jx * 16, tid, lane, wid, BST(3) ? BST(5) * 128 + (BST(4) >> 3) : (int)blockIdx.x, BST(3) ? BST(5) * 128 + 128 : NBATCH * 64, BST(3) ? 32 : (int)gridDim.x);
                else
#endif
#ifndef NO_CONV
                conv_phase(T_U, T_GB, T_A2, par + PAR_CW + jx * 3 * 1024, tid, BST(3) ? BST(5) * 64 + (BST(4) >> 3) : (int)blockIdx.x, BST(3) ? BST(5) * 64 + 64 : MROWS / 64, BST(3) ? 32 : (int)gridDim.x);
#endif
                ;
            }
        }
        if (it + 1 < DEPTH * NLS) { unsigned char* ws = a.ws; asm volatile("" : "+s"(ws));
            if (__builtin_amdgcn_readfirstlane((int)bst[3])) xcc_barrier((unsigned*)(ws + WS_BARW), (unsigned)__builtin_amdgcn_readfirstlane((int)bst[5]), 32u); else XBAR();
#ifdef DOUBLE_SEAM
            XBAR(); XBAR();
#endif
        }
    }
}

extern "C" void kernel_launch(void* const* d_in, const int* in_sizes, int n_in, void* d_out, int out_size, void* d_ws, size_t ws_size, hipStream_t stream) {
    static int grid = 0;
    if (grid == 0) {
        if (n_in != 18 || out_size != MROWS * DM || ws_size < WS_END) { fprintf(stderr, "kernel_launch: unexpected problem (n_in %d, out %d, ws %zu); nothing launched\n", n_in, out_size, ws_size); grid = -1; return; }
        int dev = 0, cus = 0, per_cu = 0;
        if (hipGetDevice(&dev) != hipSuccess || hipDeviceGetAttribute(&cus, hipDeviceAttributeMultiprocessorCount, dev) != hipSuccess) { grid = -1; return; }
        if (hipFuncSetAttribute((const void*)mk_fwd, hipFuncAttributeMaxDynamicSharedMemorySize, LDS_BYTES) != hipSuccess) { fprintf(stderr, "kernel_launch: hipFuncSetAttribute failed\n"); grid = -1; return; }
        if (hipOccupancyMaxActiveBlocksPerMultiprocessor(&per_cu, (const void*)mk_fwd, NTHREADS, LDS_BYTES) != hipSuccess || per_cu < 1) { fprintf(stderr, "kernel_launch: occupancy query says %d\n", per_cu); per_cu = 1; }
        (void)hipGetLastError();
        grid = cus * per_cu;
    }
    if (grid < 0) return;
    Args a{};
    for (int i = 0; i < 18; ++i) a.in[i] = d_in[i];
    a.out = (float*)d_out; a.ws = (unsigned char*)d_ws;
#if MK_MULTI
    for (int ph = 0; ph < NPH; ++ph) { a.ph_lo = ph; a.ph_hi = ph + 1; hipLaunchKernelGGL(mk_fwd, dim3(grid), dim3(NTHREADS), LDS_BYTES, stream, a); }
#else
    a.ph_lo = 0; a.ph_hi = NPH;
    void* args[] = {&a};
    hipError_t e = hipLaunchCooperativeKernel((const void*)mk_fwd, dim3(grid), dim3(NTHREADS), args, LDS_BYTES, stream);
    if (e != hipSuccess) fprintf(stderr, "cooperative launch failed: %s (grid %d)\n", hipGetErrorString(e), grid);
#endif
}
```
